# Optimizing an MI355X kernel written in HIP

```python
import jax, jax.numpy as jnp
from jax import lax
import numpy as np

D_MODEL = 2048
BATCH = 2
SEQ = 4096
DEPTH = 1

CHUNK = 64
ATTN_HEADS = 8
ATTN_HEAD_DIM = D_MODEL // (2 * ATTN_HEADS)
ATTN_WIDTH = ATTN_HEADS * ATTN_HEAD_DIM
LEFT_CHUNKS = 8
BAND = (LEFT_CHUNKS + 1) * CHUNK
MAX_REL = 256
REL_TABLE = MAX_REL + CHUNK
RET_HEADS = 8
RET_VALUE_DIM = D_MODEL // (2 * RET_HEADS)
RET_KEY_DIM = RET_VALUE_DIM // 2
RET_QK_WIDTH = RET_HEADS * RET_KEY_DIM
RET_V_WIDTH = RET_HEADS * RET_VALUE_DIM
ROPE_BASE = 10000.0
MIX_WIDTH = ATTN_WIDTH + RET_V_WIDTH
IN_WIDTH = 3 * ATTN_WIDTH + 2 * RET_QK_WIDTH + 2 * RET_V_WIDTH
SPLITS = [ATTN_WIDTH, 2 * ATTN_WIDTH, 3 * ATTN_WIDTH,
          3 * ATTN_WIDTH + RET_QK_WIDTH, 3 * ATTN_WIDTH + 2 * RET_QK_WIDTH,
          3 * ATTN_WIDTH + 2 * RET_QK_WIDTH + RET_V_WIDTH]
N_EXPERTS = 256
TOP_K = 8
N_GROUPS = 8
TOPK_GROUPS = 4
EXPERT_DIM = D_MODEL // 8
SHARED_DIM = EXPERT_DIM
ROUTED_SCALE = 2.5
DISPATCH_BLOCK = 64
ALPHA = (2.0 * DEPTH) ** 0.25
BETA = (8.0 * DEPTH) ** -0.25
N_MOD = 6
EPS = 1e-5

kernel_name = "hybrid_band_attn_retention_moe_block"


def layer_norm(x, gain, bias):
    xf = x.astype(jnp.float32)
    mu = jnp.mean(xf, axis=-1, keepdims=True)
    var = jnp.mean(jnp.square(xf - mu), axis=-1, keepdims=True)
    return ((xf - mu) * lax.rsqrt(var + EPS) * gain + bias).astype(x.dtype)


def rms_norm(x, gain):
    xf = x.astype(jnp.float32)
    return (xf * lax.rsqrt(jnp.mean(jnp.square(xf), axis=-1, keepdims=True) + EPS) * gain).astype(x.dtype)


def head_group_norm(x):
    xf = x.astype(jnp.float32)
    mu = jnp.mean(xf, axis=-1, keepdims=True)
    var = jnp.mean(jnp.square(xf - mu), axis=-1, keepdims=True)
    return (xf - mu) * lax.rsqrt(var + EPS)


def rotary(x):
    seq, dk = x.shape[1], x.shape[-1]
    half = dk // 2
    inv = ROPE_BASE ** (-jnp.arange(half, dtype=jnp.float32) / half)
    ang = jnp.arange(seq, dtype=jnp.float32)[:, None] * inv[None, :]
    cos, sin = jnp.cos(ang)[None, :, None, :], jnp.sin(ang)[None, :, None, :]
    x1, x2 = x[..., :half], x[..., half:]
    return jnp.concatenate([x1 * cos - x2 * sin, x2 * cos + x1 * sin], axis=-1)


def band_attention(q, k, v, rel_bias):
    b, s, h, dh = q.shape
    nc = s // CHUNK
    pad = LEFT_CHUNKS * CHUNK
    kp = jnp.pad(k, ((0, 0), (pad, 0), (0, 0), (0, 0))).reshape(b, nc + LEFT_CHUNKS, CHUNK, h, dh)
    vp = jnp.pad(v, ((0, 0), (pad, 0), (0, 0), (0, 0))).reshape(b, nc + LEFT_CHUNKS, CHUNK, h, dh)
    k_band = jnp.concatenate([kp[:, w:w + nc] for w in range(LEFT_CHUNKS + 1)], axis=2)
    v_band = jnp.concatenate([vp[:, w:w + nc] for w in range(LEFT_CHUNKS + 1)], axis=2)
    qc = q.reshape(b, nc, CHUNK, h, dh)
    scores = jnp.einsum('bcihd,bcjhd->bhcij', qc, k_band).astype(jnp.float32) * (dh ** -0.5)
    qi = jnp.arange(CHUNK)[:, None]
    kj = jnp.arange(BAND)[None, :]
    dist = pad + qi - kj
    rel_idx = jnp.clip(dist, -(CHUNK - 1), MAX_REL) + (CHUNK - 1)
    bias = rel_bias[:, rel_idx].astype(jnp.float32)
    key_pos = jnp.arange(nc)[:, None] * CHUNK - pad + kj
    valid = key_pos >= 0
    scores = jnp.where(valid[None, None, :, None, :], scores + bias[None, :, None], -jnp.inf)
    probs = jax.nn.softmax(scores, axis=-1).astype(v.dtype)
    out = jnp.einsum('bhcij,bcjhd->bcihd', probs, v_band)
    return out.reshape(b, s, h * dh)


def retention(q, k, v):
    q, k, v = q.astype(jnp.float32), k.astype(jnp.float32), v.astype(jnp.float32)
    b, s, h, dk = q.shape
    dv = v.shape[-1]
    nc = s // CHUNK
    log_g = jnp.log(1.0 - 2.0 ** (-5.0 - jnp.arange(h, dtype=jnp.float32)))
    n = jnp.arange(CHUNK, dtype=jnp.float32)
    d_intra = jnp.exp(log_g[:, None, None] * jnp.abs(n[:, None] - n[None, :]))
    xi = jnp.exp(log_g[None, :] * (n[:, None] + 1.0))
    zeta = jnp.exp(log_g[None, :] * (CHUNK - 1.0 - n[:, None]))
    g_chunk = jnp.exp(log_g * CHUNK)
    k = k * (dk ** -0.5)
    qc = q.reshape(b, nc, CHUNK, h, dk)
    kc = k.reshape(b, nc, CHUNK, h, dk)
    vc = v.reshape(b, nc, CHUNK, h, dv)
    intra_scores = jnp.einsum('bcnhk,bcmhk->bchnm', qc, kc) * d_intra[None, None]
    intra = jnp.einsum('bchnm,bcmhv->bcnhv', intra_scores, vc)
    updates = jnp.einsum('bcmhk,bcmhv->chkvb', kc * zeta[None, None, :, :, None], vc)

    def step(state, u):
        return g_chunk[:, None, None, None] * state + u, state

    _, r_prev = lax.scan(step, jnp.zeros((h, dk, dv, b), jnp.float32), updates)
    cross = jnp.einsum('bcnhk,chkvb->bcnhv', qc * xi[None, None, :, :, None], r_prev)
    return (intra + cross).reshape(b, s, h, dv)


def token_mixer(h, w_in, rel_bias, attn_gain, ret_gain, w_out):
    b, s, _ = h.shape
    proj = h @ w_in
    qa, ka, va, qb, kb, vb, gb = jnp.split(proj, SPLITS, axis=-1)
    qa = qa.reshape(b, s, ATTN_HEADS, ATTN_HEAD_DIM)
    ka = ka.reshape(b, s, ATTN_HEADS, ATTN_HEAD_DIM)
    va = va.reshape(b, s, ATTN_HEADS, ATTN_HEAD_DIM)
    y_a = rms_norm(band_attention(qa, ka, va, rel_bias), attn_gain)
    qb = rotary(qb.reshape(b, s, RET_HEADS, RET_KEY_DIM))
    kb = rotary(kb.reshape(b, s, RET_HEADS, RET_KEY_DIM))
    vb = vb.reshape(b, s, RET_HEADS, RET_VALUE_DIM)
    ret = head_group_norm(retention(qb, kb, vb)).reshape(b, s, RET_V_WIDTH)
    y_b = (jax.nn.silu(gb.astype(jnp.float32)) * ret * ret_gain).astype(h.dtype)
    return jnp.concatenate([y_a, y_b], axis=-1) @ w_out


def swiglu(x, wg, wu, wd):
    return (jax.nn.silu(x @ wg) * (x @ wu)) @ wd


def moe_ffn(h, w_router, router_bias, w_gate, w_up, w_down, ws_gate, ws_up, ws_down):
    t, d = h.shape
    scores = jax.nn.sigmoid((h @ w_router).astype(jnp.float32))
    biased = scores + router_bias.astype(jnp.float32)
    per_group = N_EXPERTS // N_GROUPS
    grp_score = lax.top_k(biased.reshape(t, N_GROUPS, per_group), 2)[0].sum(-1)
    _, top_grp = lax.top_k(grp_score, TOPK_GROUPS)
    grp_mask = jnp.any(top_grp[:, :, None] == jnp.arange(N_GROUPS)[None, None, :], axis=1)
    masked = jnp.where(jnp.repeat(grp_mask, per_group, axis=1), biased, -jnp.inf)
    _, idx = lax.top_k(masked, TOP_K)
    w = jnp.take_along_axis(scores, idx, axis=1)
    w = w / jnp.sum(w, axis=-1, keepdims=True) * ROUTED_SCALE

    n_assign = t * TOP_K
    flat_e = idx.reshape(-1)
    flat_tok = jnp.repeat(jnp.arange(t, dtype=jnp.int32), TOP_K)
    flat_w = w.reshape(-1)
    order = jnp.argsort(flat_e)
    e_sorted = flat_e[order]
    counts = jnp.bincount(flat_e, length=N_EXPERTS)
    start = jnp.cumsum(counts) - counts
    padded = (counts + DISPATCH_BLOCK - 1) // DISPATCH_BLOCK * DISPATCH_BLOCK
    pend = jnp.cumsum(padded)
    pstart = pend - padded
    dest = pstart[e_sorted] + (jnp.arange(n_assign) - start[e_sorted])
    buf = n_assign + N_EXPERTS * DISPATCH_BLOCK
    n_blocks = buf // DISPATCH_BLOCK
    tok_buf = jnp.full((buf,), t, jnp.int32).at[dest].set(flat_tok[order]).reshape(n_blocks, DISPATCH_BLOCK)
    w_buf = jnp.zeros((buf,), jnp.float32).at[dest].set(flat_w[order]).reshape(n_blocks, DISPATCH_BLOCK)
    blk_expert = jnp.minimum(
        jnp.searchsorted(pend, jnp.arange(n_blocks) * DISPATCH_BLOCK, side='right'), N_EXPERTS - 1)
    h_pad = jnp.concatenate([h, jnp.zeros((1, d), h.dtype)], axis=0)

    def step(acc, blk):
        tok, wb, e = blk
        y = swiglu(h_pad[tok], w_gate[e], w_up[e], w_down[e])
        return acc.at[tok].add((y * wb[:, None]).astype(acc.dtype)), None

    routed, _ = lax.scan(step, jnp.zeros((t + 1, d), h.dtype), (tok_buf, w_buf, blk_expert))
    return routed[:t] + swiglu(h, ws_gate, ws_up, ws_down)


def setup_inputs(seed: int = 0) -> dict:
    key = jax.random.key(seed)
    ks = jax.random.split(key, 21)
    L, D = DEPTH, D_MODEL

    def nrm(k, shape, scale):
        return jax.random.normal(k, shape, jnp.float32) * scale

    col_scale = jnp.concatenate([
        jnp.ones((2 * ATTN_WIDTH,), jnp.float32), jnp.full((ATTN_WIDTH,), BETA, jnp.float32),
        jnp.ones((2 * RET_QK_WIDTH,), jnp.float32), jnp.full((RET_V_WIDTH,), BETA, jnp.float32),
        jnp.ones((RET_V_WIDTH,), jnp.float32)])
    return {
        "x": nrm(ks[0], (BATCH, SEQ, D), 1.0),
        "c": nrm(ks[1], (BATCH, D), 1.0),
        "w_ada": nrm(ks[2], (L, D, N_MOD * D), 0.5 * D ** -0.5),
        "b_ada": nrm(ks[3], (L, N_MOD * D), 0.02),
        "w_in": nrm(ks[4], (L, D, IN_WIDTH), D ** -0.5) * col_scale,
        "rel_bias": nrm(ks[5], (L, ATTN_HEADS, REL_TABLE), 0.5),
        "attn_gain": 1.0 + nrm(ks[6], (L, ATTN_WIDTH), 0.02),
        "ret_gain": 1.0 + nrm(ks[7], (L, RET_V_WIDTH), 0.02),
        "w_out": nrm(ks[8], (L, MIX_WIDTH, D), BETA * MIX_WIDTH ** -0.5),
        "ln1_gain": 1.0 + nrm(ks[9], (L, D), 0.02),
        "ln1_bias": nrm(ks[10], (L, D), 0.02),
        "w_router": nrm(ks[11], (L, D, N_EXPERTS), D ** -0.5),
        "router_bias": nrm(ks[12], (L, N_EXPERTS), 0.01),
        "w_gate": nrm(ks[13], (L, N_EXPERTS, D, EXPERT_DIM), D ** -0.5),
        "w_up": nrm(ks[14], (L, N_EXPERTS, D, EXPERT_DIM), D ** -0.5),
        "w_down": nrm(ks[15], (L, N_EXPERTS, EXPERT_DIM, D), BETA * EXPERT_DIM ** -0.5),
        "ws_gate": nrm(ks[16], (L, D, SHARED_DIM), D ** -0.5),
        "ws_up": nrm(ks[17], (L, D, SHARED_DIM), D ** -0.5),
        "ws_down": nrm(ks[18], (L, SHARED_DIM, D), BETA * SHARED_DIM ** -0.5),
        "ln2_gain": 1.0 + nrm(ks[19], (L, D), 0.02),
        "ln2_bias": nrm(ks[20], (L, D), 0.02),
    }


def reference(x, c, w_ada, b_ada, w_in, rel_bias, attn_gain, ret_gain, w_out, ln1_gain, ln1_bias,
              w_router, router_bias, w_gate, w_up, w_down, ws_gate, ws_up, ws_down, ln2_gain, ln2_bias):
    b, s, d = x.shape
    for l in range(DEPTH):
        mod = jax.nn.silu(c) @ w_ada[l] + b_ada[l]
        sh1, sc1, g1, sh2, sc2, g2 = jnp.split(mod[:, None, :], N_MOD, axis=-1)
        h = x * (1.0 + sc1) + sh1
        y = token_mixer(h, w_in[l], rel_bias[l], attn_gain[l], ret_gain[l], w_out[l])
        x = layer_norm(ALPHA * x + g1 * y, ln1_gain[l], ln1_bias[l])
        h = x * (1.0 + sc2) + sh2
        y = moe_ffn(h.reshape(b * s, d), w_router[l], router_bias[l], w_gate[l], w_up[l], w_down[l],
                    ws_gate[l], ws_up[l], ws_down[l]).reshape(b, s, d)
        x = layer_norm(ALPHA * x + g2 * y, ln2_gain[l], ln2_bias[l])
    return x
```

```cpp
#include <hip/hip_runtime.h>
#include <cstdint>
#include <cstdio>

#define D_MODEL 2048
#define BATCH 2
#define SEQ 4096
#define NTOK 8192
#define IN_WIDTH 6144
#define NEXP 256
#define TOPK 8
#define EDIM 256
#define CHUNK 64
#define NCHUNK 64
#define ALPHA_F 1.189207115002721f
#define EPS_F 1e-5f

__device__ __forceinline__ float silu_f(float v) { return v / (1.0f + __expf(-v)); }
__device__ __forceinline__ float sigmoid_f(float v) { return 1.0f / (1.0f + __expf(-v)); }

__global__ void __launch_bounds__(256) k_mod(const float* __restrict__ c, const float* __restrict__ w_ada, const float* __restrict__ b_ada, float* __restrict__ mod) {
    const int n = blockIdx.x * 256 + threadIdx.x, b = blockIdx.y;
    float acc = 0.f;
    for (int k = 0; k < D_MODEL; ++k) acc += silu_f(c[b * D_MODEL + k]) * w_ada[(size_t)k * (6 * D_MODEL) + n];
    mod[b * 6 * D_MODEL + n] = acc + b_ada[n];
}
__global__ void k_rope(float* __restrict__ cs) {
    const int i = blockIdx.x * 256 + threadIdx.x; if (i >= SEQ * 32) return;
    const int s = i >> 5, j = i & 31;
    const float inv = powf(10000.0f, -(float)j / 32.0f);
    const float ang = (float)s * inv;
    cs[2 * i] = cosf(ang); cs[2 * i + 1] = sinf(ang);
}
__global__ void __launch_bounds__(256) k_modulate(const float* __restrict__ x, const float* __restrict__ mod, int sh_off, int sc_off, float* __restrict__ h) {
    const size_t i = (size_t)blockIdx.x * 256 + threadIdx.x;
    const int t = (int)(i / D_MODEL), d = (int)(i % D_MODEL), b = t / SEQ;
    h[i] = x[i] * (1.0f + mod[b * 6 * D_MODEL + sc_off + d]) + mod[b * 6 * D_MODEL + sh_off + d];
}
__global__ void __launch_bounds__(256) k_gemm(const float* __restrict__ A, int lda, const float* __restrict__ B, int ldb, float* __restrict__ C, int ldc, int K) {
    __shared__ float As[16][68];
    __shared__ float Bs[16][68];
    const int tid = threadIdx.x, tx = tid & 15, ty = tid >> 4;
    const int m0 = blockIdx.y * 64, n0 = blockIdx.x * 64;
    float acc[4][4];
#pragma unroll
    for (int i = 0; i < 4; ++i)
#pragma unroll
        for (int j = 0; j < 4; ++j) acc[i][j] = 0.f;
    for (int k0 = 0; k0 < K; k0 += 16) {
        {
            const int r = tid >> 2, c4 = (tid & 3) * 4;
            const float4 v = *(const float4*)(A + (size_t)(m0 + r) * lda + k0 + c4);
            As[c4 + 0][r] = v.x; As[c4 + 1][r] = v.y; As[c4 + 2][r] = v.z; As[c4 + 3][r] = v.w;
            const int kr = tid >> 4, cc = (tid & 15) * 4;
            const float4 w = *(const float4*)(B + (size_t)(k0 + kr) * ldb + n0 + cc);
            Bs[kr][cc + 0] = w.x; Bs[kr][cc + 1] = w.y; Bs[kr][cc + 2] = w.z; Bs[kr][cc + 3] = w.w;
        }
        __syncthreads();
#pragma unroll
        for (int kk = 0; kk < 16; ++kk) {
            float a[4], b[4];
#pragma unroll
            for (int i = 0; i < 4; ++i) a[i] = As[kk][ty * 4 + i];
#pragma unroll
            for (int j = 0; j < 4; ++j) b[j] = Bs[kk][tx * 4 + j];
#pragma unroll
            for (int i = 0; i < 4; ++i)
#pragma unroll
                for (int j = 0; j < 4; ++j) acc[i][j] += a[i] * b[j];
        }
        __syncthreads();
    }
#pragma unroll
    for (int i = 0; i < 4; ++i)
#pragma unroll
        for (int j = 0; j < 4; ++j) C[(size_t)(m0 + ty * 4 + i) * ldc + n0 + tx * 4 + j] = acc[i][j];
}
__global__ void __launch_bounds__(256) k_band_attn(const float* __restrict__ proj, const float* __restrict__ rel_bias, float* __restrict__ attn_out) {
    const int c = blockIdx.x, h = blockIdx.y, b = blockIdx.z;
    const int tid = threadIdx.x, i = tid >> 2, part = tid & 3;
    const size_t tq = (size_t)b * SEQ + c * 64 + i;
    float q[32], o[32];
    const float scale = 0.08838834764831845f;
#pragma unroll
    for (int d = 0; d < 32; ++d) { q[d] = proj[tq * IN_WIDTH + h * 128 + part * 32 + d] * scale; o[d] = 0.f; }
    float m = -1e30f, l = 0.f;
    for (int j = 0; j < 576; ++j) {
        const int kpos = c * 64 - 512 + j;
        if (kpos < 0) continue;
        const size_t tk = (size_t)b * SEQ + kpos;
        const float* kp = proj + tk * IN_WIDTH + 1024 + h * 128 + part * 32;
        float s = 0.f;
#pragma unroll
        for (int d = 0; d < 32; ++d) s += q[d] * kp[d];
        s += __shfl_xor(s, 1); s += __shfl_xor(s, 2);
        int dist = 512 + i - j; dist = dist < -63 ? -63 : (dist > 256 ? 256 : dist);
        s += rel_bias[h * 320 + dist + 63];
        const float mn = fmaxf(m, s), a = __expf(m - mn), p = __expf(s - mn);
        l = l * a + p; m = mn;
        const float* vp = proj + tk * IN_WIDTH + 2048 + h * 128 + part * 32;
#pragma unroll
        for (int d = 0; d < 32; ++d) o[d] = o[d] * a + p * vp[d];
    }
    const float il = 1.0f / l;
#pragma unroll
    for (int d = 0; d < 32; ++d) attn_out[tq * 1024 + h * 128 + part * 32 + d] = o[d] * il;
}
__global__ void __launch_bounds__(256) k_rms(const float* __restrict__ attn_out, const float* __restrict__ gain, float* __restrict__ ycat) {
    __shared__ float red[4];
    const int t = blockIdx.x, tid = threadIdx.x;
    float v[4]; float ss = 0.f;
#pragma unroll
    for (int j = 0; j < 4; ++j) { v[j] = attn_out[(size_t)t * 1024 + tid + 256 * j]; ss += v[j] * v[j]; }
    for (int o = 32; o > 0; o >>= 1) ss += __shfl_xor(ss, o);
    if ((tid & 63) == 0) red[tid >> 6] = ss;
    __syncthreads();
    const float tot = red[0] + red[1] + red[2] + red[3];
    const float rs = rsqrtf(tot / 1024.0f + EPS_F);
#pragma unroll
    for (int j = 0; j < 4; ++j) ycat[(size_t)t * D_MODEL + tid + 256 * j] = v[j] * rs * gain[tid + 256 * j];
}
__global__ void __launch_bounds__(256) k_rot(const float* __restrict__ proj, const float* __restrict__ cs, float* __restrict__ qr, float* __restrict__ kr) {
    const size_t i = (size_t)blockIdx.x * 256 + threadIdx.x;
    const int j = (int)(i & 31), h = (int)((i >> 5) & 7); const size_t t = i >> 8; const int s = (int)(t % SEQ);
    const float co = cs[(s * 32 + j) * 2], si = cs[(s * 32 + j) * 2 + 1];
    const float* pq = proj + t * IN_WIDTH + 3072 + h * 64; const float* pk = proj + t * IN_WIDTH + 3584 + h * 64;
    const float q1 = pq[j], q2 = pq[j + 32], k1 = pk[j], k2 = pk[j + 32];
    qr[t * 512 + h * 64 + j] = q1 * co - q2 * si; qr[t * 512 + h * 64 + 32 + j] = q2 * co + q1 * si;
    kr[t * 512 + h * 64 + j] = (k1 * co - k2 * si) * 0.125f; kr[t * 512 + h * 64 + 32 + j] = (k2 * co + k1 * si) * 0.125f;
}
__device__ __forceinline__ float log_gamma(int h) { return logf(1.0f - exp2f(-5.0f - (float)h)); }
__global__ void __launch_bounds__(256) k_ret_u(const float* __restrict__ proj, const float* __restrict__ kr, float* __restrict__ U) {
    const int c = blockIdx.x, h = blockIdx.y, b = blockIdx.z, tid = threadIdx.x, kk = tid >> 2, part = tid & 3;
    const float lg = log_gamma(h);
    float acc[32];
#pragma unroll
    for (int d = 0; d < 32; ++d) acc[d] = 0.f;
    for (int m = 0; m < 64; ++m) {
        const size_t t = (size_t)b * SEQ + c * 64 + m;
        const float kv = kr[t * 512 + h * 64 + kk] * __expf(lg * (float)(63 - m));
        const float* vp = proj + t * IN_WIDTH + 4096 + h * 128 + part * 32;
#pragma unroll
        for (int d = 0; d < 32; ++d) acc[d] += kv * vp[d];
    }
    float* up = U + ((((size_t)b * 8 + h) * 64 + c) * 64 + kk) * 128 + part * 32;
#pragma unroll
    for (int d = 0; d < 32; ++d) up[d] = acc[d];
}
__global__ void __launch_bounds__(256) k_ret_scan(const float* __restrict__ U, float* __restrict__ R) {
    const int i = blockIdx.x * 256 + threadIdx.x;
    const int e = i & 8191, bh = i >> 13, h = bh & 7;
    const float g = __expf(log_gamma(h) * 64.0f);
    float st = 0.f;
    for (int c = 0; c < 64; ++c) { const size_t o = ((size_t)bh * 64 + c) * 8192 + e; R[o] = st; st = g * st + U[o]; }
}
__global__ void __launch_bounds__(256) k_ret_out(const float* __restrict__ proj, const float* __restrict__ qr, const float* __restrict__ kr, const float* __restrict__ R,
                                                 const float* __restrict__ ret_gain, float* __restrict__ ycat) {
    const int c = blockIdx.x, h = blockIdx.y, b = blockIdx.z, tid = threadIdx.x, n = tid >> 2, part = tid & 3;
    const float lg = log_gamma(h);
    const size_t tn = (size_t)b * SEQ + c * 64 + n;
    float q[16], o[32];
#pragma unroll
    for (int d = 0; d < 16; ++d) q[d] = qr[tn * 512 + h * 64 + part * 16 + d];
#pragma unroll
    for (int d = 0; d < 32; ++d) o[d] = 0.f;
    for (int m = 0; m < 64; ++m) {
        const size_t tm = (size_t)b * SEQ + c * 64 + m;
        const float* kp = kr + tm * 512 + h * 64 + part * 16;
        float s = 0.f;
#pragma unroll
        for (int d = 0; d < 16; ++d) s += q[d] * kp[d];
        s += __shfl_xor(s, 1); s += __shfl_xor(s, 2);
        const int dd = n > m ? n - m : m - n;
        s *= __expf(lg * (float)dd);
        const float* vp = proj + tm * IN_WIDTH + 4096 + h * 128 + part * 32;
#pragma unroll
        for (int d = 0; d < 32; ++d) o[d] += s * vp[d];
    }
    const float xi = __expf(lg * (float)(n + 1));
    const float* Rp = R + (((size_t)b * 8 + h) * 64 + c) * 8192;
    for (int kk = 0; kk < 64; ++kk) {
        const float qv = qr[tn * 512 + h * 64 + kk] * xi;
        const float* rp = Rp + kk * 128 + part * 32;
#pragma unroll
        for (int d = 0; d < 32; ++d) o[d] += qv * rp[d];
    }
    float s1 = 0.f;
#pragma unroll
    for (int d = 0; d < 32; ++d) s1 += o[d];
    s1 += __shfl_xor(s1, 1); s1 += __shfl_xor(s1, 2);
    const float mu = s1 / 128.0f; float s2 = 0.f;
#pragma unroll
    for (int d = 0; d < 32; ++d) { const float dv = o[d] - mu; s2 += dv * dv; }
    s2 += __shfl_xor(s2, 1); s2 += __shfl_xor(s2, 2);
    const float rs = rsqrtf(s2 / 128.0f + EPS_F);
#pragma unroll
    for (int d = 0; d < 32; ++d) {
        const int col = h * 128 + part * 32 + d;
        const float gb = proj[tn * IN_WIDTH + 5120 + col];
        ycat[tn * D_MODEL + 1024 + col] = silu_f(gb) * (o[d] - mu) * rs * ret_gain[col];
    }
}
__global__ void __launch_bounds__(256) k_res_ln(const float* __restrict__ xres, const float* __restrict__ y, const float* __restrict__ y2, const float* __restrict__ mod, int g_off,
                                                const float* __restrict__ gain, const float* __restrict__ bias, float* __restrict__ xo, int sh_off, int sc_off, float* __restrict__ hmod) {
    __shared__ float red[4];
    const int t = blockIdx.x, tid = threadIdx.x, b = t / SEQ;
    float z[8]; float s = 0.f;
#pragma unroll
    for (int j = 0; j < 8; ++j) {
        const int d = tid + 256 * j; float yy = y[(size_t)t * D_MODEL + d]; if (y2) yy += y2[(size_t)t * D_MODEL + d];
        z[j] = ALPHA_F * xres[(size_t)t * D_MODEL + d] + mod[b * 6 * D_MODEL + g_off + d] * yy; s += z[j];
    }
    for (int o = 32; o > 0; o >>= 1) s += __shfl_xor(s, o);
    if ((tid & 63) == 0) red[tid >> 6] = s;
    __syncthreads();
    const float mu = (red[0] + red[1] + red[2] + red[3]) / (float)D_MODEL;
    __syncthreads();
    float q = 0.f;
#pragma unroll
    for (int j = 0; j < 8; ++j) { const float dv = z[j] - mu; q += dv * dv; }
    for (int o = 32; o > 0; o >>= 1) q += __shfl_xor(q, o);
    if ((tid & 63) == 0) red[tid >> 6] = q;
    __syncthreads();
    const float rs = rsqrtf((red[0] + red[1] + red[2] + red[3]) / (float)D_MODEL + EPS_F);
#pragma unroll
    for (int j = 0; j < 8; ++j) {
        const int d = tid + 256 * j; const float v = (z[j] - mu) * rs * gain[d] + bias[d];
        xo[(size_t)t * D_MODEL + d] = v;
        if (hmod) hmod[(size_t)t * D_MODEL + d] = v * (1.0f + mod[b * 6 * D_MODEL + sc_off + d]) + mod[b * 6 * D_MODEL + sh_off + d];
    }
}
__global__ void __launch_bounds__(256) k_route(const float* __restrict__ logits, const float* __restrict__ rbias, int* __restrict__ counts, int* __restrict__ lists,
                                               int* __restrict__ a_exp, float* __restrict__ a_w) {
    __shared__ float sb[256], ssc[256]; __shared__ float gs[8]; __shared__ int gsel[8]; __shared__ int pick[8];
    const int t = blockIdx.x, e = threadIdx.x;
    const float sc = sigmoid_f(logits[(size_t)t * NEXP + e]); const float bi = sc + rbias[e];
    ssc[e] = sc; sb[e] = bi;
    __syncthreads();
    if (e < 8) { float t1 = -1e30f, t2 = -1e30f; for (int i = 0; i < 32; ++i) { const float v = sb[e * 32 + i]; if (v > t1) { t2 = t1; t1 = v; } else if (v > t2) t2 = v; } gs[e] = t1 + t2; gsel[e] = 0; }
    __syncthreads();
    if (e == 0) {
        for (int r = 0; r < 4; ++r) { int bi_ = -1; float bv = -1e30f; for (int g = 0; g < 8; ++g) if (!gsel[g] && gs[g] > bv) { bv = gs[g]; bi_ = g; } gsel[bi_] = 1; }
    }
    __syncthreads();
    if (!gsel[e >> 5]) sb[e] = -1e30f;
    __syncthreads();
    if (e == 0) {
        float wsum = 0.f;
        for (int r = 0; r < 8; ++r) { int bi_ = 0; float bv = -2e30f; for (int i = 0; i < 256; ++i) if (sb[i] > bv) { bv = sb[i]; bi_ = i; } pick[r] = bi_; sb[bi_] = -3e30f; wsum += ssc[bi_]; }
        for (int r = 0; r < 8; ++r) {
            const int ex = pick[r]; const int slot = atomicAdd(&counts[ex], 1);
            lists[ex * NTOK + slot] = t * 8 + r; a_exp[t * 8 + r] = ex; a_w[t * 8 + r] = ssc[ex] / wsum * 2.5f;
        }
    }
}
__global__ void __launch_bounds__(256) k_moe_gu(const float* __restrict__ h2, const float* __restrict__ wg, const float* __restrict__ wu, const int* __restrict__ counts,
                                                const int* __restrict__ lists, float* __restrict__ act) {
    __shared__ float hs[8][256];
    const int e = blockIdx.y, tile = blockIdx.x, j = threadIdx.x;
    const int cnt = counts[e]; if (tile * 8 >= cnt) return;
    int aid[8];
#pragma unroll
    for (int i = 0; i < 8; ++i) { const int s = tile * 8 + i; aid[i] = s < cnt ? lists[e * NTOK + s] : -1; }
    float ag[8], au[8];
#pragma unroll
    for (int i = 0; i < 8; ++i) { ag[i] = 0.f; au[i] = 0.f; }
    const float* wgp = wg + (size_t)e * D_MODEL * EDIM; const float* wup = wu + (size_t)e * D_MODEL * EDIM;
    for (int k0 = 0; k0 < D_MODEL; k0 += 256) {
        __syncthreads();
#pragma unroll
        for (int i = 0; i < 8; ++i) hs[i][j] = aid[i] >= 0 ? h2[(size_t)(aid[i] >> 3) * D_MODEL + k0 + j] : 0.f;
        __syncthreads();
        for (int kk = 0; kk < 256; ++kk) {
            const float a = wgp[(size_t)(k0 + kk) * EDIM + j], u = wup[(size_t)(k0 + kk) * EDIM + j];
#pragma unroll
            for (int i = 0; i < 8; ++i) { const float hv = hs[i][kk]; ag[i] += hv * a; au[i] += hv * u; }
        }
    }
#pragma unroll
    for (int i = 0; i < 8; ++i) if (aid[i] >= 0) act[(size_t)aid[i] * EDIM + j] = silu_f(ag[i]) * au[i];
}
__global__ void __launch_bounds__(256) k_moe_down(const float* __restrict__ act, const float* __restrict__ wd, const int* __restrict__ counts, const int* __restrict__ lists,
                                                  const float* __restrict__ a_w, float* __restrict__ contrib) {
    __shared__ float as[8][256];
    const int e = blockIdx.y, tile = blockIdx.x, half = blockIdx.z, j = threadIdx.x;
    const int cnt = counts[e]; if (tile * 8 >= cnt) return;
    int aid[8];
#pragma unroll
    for (int i = 0; i < 8; ++i) { const int s = tile * 8 + i; aid[i] = s < cnt ? lists[e * NTOK + s] : -1; }
#pragma unroll
    for (int i = 0; i < 8; ++i) as[i][j] = aid[i] >= 0 ? act[(size_t)aid[i] * EDIM + j] : 0.f;
    __syncthreads();
    float acc[4][8];
#pragma unroll
    for (int c = 0; c < 4; ++c)
#pragma unroll
        for (int i = 0; i < 8; ++i) acc[c][i] = 0.f;
    const float* wp = wd + (size_t)e * EDIM * D_MODEL + half * 1024 + j;
    for (int kk = 0; kk < 256; ++kk) {
        float w[4];
#pragma unroll
        for (int c = 0; c < 4; ++c) w[c] = wp[(size_t)kk * D_MODEL + 256 * c];
#pragma unroll
        for (int i = 0; i < 8; ++i) { const float a = as[i][kk];
#pragma unroll
            for (int c = 0; c < 4; ++c) acc[c][i] += a * w[c]; }
    }
#pragma unroll
    for (int i = 0; i < 8; ++i) if (aid[i] >= 0) { const float rw = a_w[aid[i]];
#pragma unroll
        for (int c = 0; c < 4; ++c) contrib[(size_t)aid[i] * D_MODEL + half * 1024 + j + 256 * c] = rw * acc[c][i]; }
}
__global__ void __launch_bounds__(256) k_swiglu_act(const float* __restrict__ gu, float* __restrict__ act) {
    const size_t i = (size_t)blockIdx.x * 256 + threadIdx.x; const size_t t = i >> 8; const int j = (int)(i & 255);
    act[i] = silu_f(gu[t * 512 + j]) * gu[t * 512 + 256 + j];
}
__global__ void __launch_bounds__(256) k_combine(const float* __restrict__ contrib, const float* __restrict__ sh_out, float* __restrict__ ffn) {
    const size_t i = (size_t)blockIdx.x * 256 + threadIdx.x; const size_t t = i / D_MODEL; const int d = (int)(i % D_MODEL);
    float s = sh_out[i];
#pragma unroll
    for (int k = 0; k < 8; ++k) s += contrib[(t * 8 + k) * D_MODEL + d];
    ffn[i] = s;
}

extern "C" void kernel_launch(void* const* d_in, const int* in_sizes, int n_in, void* d_out, int out_size, void* d_ws, size_t ws_size, hipStream_t stream) {
    const float* x = (const float*)d_in[0]; const float* c = (const float*)d_in[1]; const float* w_ada = (const float*)d_in[2]; const float* b_ada = (const float*)d_in[3];
    const float* w_in = (const float*)d_in[4]; const float* rel_bias = (const float*)d_in[5]; const float* attn_gain = (const float*)d_in[6]; const float* ret_gain = (const float*)d_in[7];
    const float* w_out = (const float*)d_in[8]; const float* ln1_g = (const float*)d_in[9]; const float* ln1_b = (const float*)d_in[10]; const float* w_router = (const float*)d_in[11];
    const float* router_bias = (const float*)d_in[12]; const float* w_gate = (const float*)d_in[13]; const float* w_up = (const float*)d_in[14]; const float* w_down = (const float*)d_in[15];
    const float* ws_gate = (const float*)d_in[16]; const float* ws_up = (const float*)d_in[17]; const float* ws_down = (const float*)d_in[18]; const float* ln2_g = (const float*)d_in[19];
    const float* ln2_b = (const float*)d_in[20];
    float* out = (float*)d_out;
    char* w = (char*)d_ws; size_t off = 0;
    auto carve = [&](size_t bytes) { void* p = w + off; off += (bytes + 255) & ~(size_t)255; return p; };
    int* counts = (int*)carve(NEXP * 4);
    float* mod = (float*)carve(2 * 6 * D_MODEL * 4);
    float* cs = (float*)carve(SEQ * 32 * 2 * 4);
    float* h1 = (float*)carve((size_t)NTOK * D_MODEL * 4);
    float* proj = (float*)carve((size_t)NTOK * IN_WIDTH * 4);
    float* qr = (float*)carve((size_t)NTOK * 512 * 4);
    float* kr = (float*)carve((size_t)NTOK * 512 * 4);
    float* attn_out = (float*)carve((size_t)NTOK * 1024 * 4);
    float* U = (float*)carve((size_t)2 * 8 * 64 * 8192 * 4);
    float* R = (float*)carve((size_t)2 * 8 * 64 * 8192 * 4);
    float* ycat = (float*)carve((size_t)NTOK * D_MODEL * 4);
    float* mixer = (float*)carve((size_t)NTOK * D_MODEL * 4);
    float* x1 = (float*)carve((size_t)NTOK * D_MODEL * 4);
    float* h2 = (float*)carve((size_t)NTOK * D_MODEL * 4);
    float* logits = (float*)carve((size_t)NTOK * NEXP * 4);
    int* lists = (int*)carve((size_t)NEXP * NTOK * 4);
    int* a_exp = (int*)carve((size_t)NTOK * 8 * 4);
    float* a_w = (float*)carve((size_t)NTOK * 8 * 4);
    float* act = (float*)carve((size_t)NTOK * 8 * EDIM * 4);
    float* contrib = (float*)carve((size_t)NTOK * 8 * D_MODEL * 4);
    float* sgu = (float*)carve((size_t)NTOK * 512 * 4);
    float* sact = (float*)carve((size_t)NTOK * 256 * 4);
    float* sh_out = (float*)carve((size_t)NTOK * D_MODEL * 4);
    float* ffn = (float*)carve((size_t)NTOK * D_MODEL * 4);
    if (off > ws_size) { fprintf(stderr, "workspace too small: need %zu have %zu\n", off, ws_size); return; }

    hipMemsetAsync(counts, 0, NEXP * 4, stream);
    k_mod<<<dim3(6 * D_MODEL / 256, 2), 256, 0, stream>>>(c, w_ada, b_ada, mod);
    k_rope<<<SEQ * 32 / 256, 256, 0, stream>>>(cs);
    k_modulate<<<NTOK * D_MODEL / 256, 256, 0, stream>>>(x, mod, 0, D_MODEL, h1);
    k_gemm<<<dim3(IN_WIDTH / 64, NTOK / 64), 256, 0, stream>>>(h1, D_MODEL, w_in, IN_WIDTH, proj, IN_WIDTH, D_MODEL);
    k_band_attn<<<dim3(64, 8, 2), 256, 0, stream>>>(proj, rel_bias, attn_out);
    k_rms<<<NTOK, 256, 0, stream>>>(attn_out, attn_gain, ycat);
    k_rot<<<NTOK * 256 / 256, 256, 0, stream>>>(proj, cs, qr, kr);
    k_ret_u<<<dim3(64, 8, 2), 256, 0, stream>>>(proj, kr, U);
    k_ret_scan<<<2 * 8 * 8192 / 256, 256, 0, stream>>>(U, R);
    k_ret_out<<<dim3(64, 8, 2), 256, 0, stream>>>(proj, qr, kr, R, ret_gain, ycat);
    k_gemm<<<dim3(D_MODEL / 64, NTOK / 64), 256, 0, stream>>>(ycat, D_MODEL, w_out, D_MODEL, mixer, D_MODEL, D_MODEL);
    k_res_ln<<<NTOK, 256, 0, stream>>>(x, mixer, nullptr, mod, 2 * D_MODEL, ln1_g, ln1_b, x1, 3 * D_MODEL, 4 * D_MODEL, h2);
    k_gemm<<<dim3(NEXP / 64, NTOK / 64), 256, 0, stream>>>(h2, D_MODEL, w_router, NEXP, logits, NEXP, D_MODEL);
    k_route<<<NTOK, 256, 0, stream>>>(logits, router_bias, counts, lists, a_exp, a_w);
    k_moe_gu<<<dim3(NTOK / 8, NEXP), 256, 0, stream>>>(h2, w_gate, w_up, counts, lists, act);
    k_moe_down<<<dim3(NTOK / 8, NEXP, 2), 256, 0, stream>>>(act, w_down, counts, lists, a_w, contrib);
    k_gemm<<<dim3(256 / 64, NTOK / 64), 256, 0, stream>>>(h2, D_MODEL, ws_gate, 256, sgu, 512, D_MODEL);
    k_gemm<<<dim3(256 / 64, NTOK / 64), 256, 0, stream>>>(h2, D_MODEL, ws_up, 256, sgu + 256, 512, D_MODEL);
    k_swiglu_act<<<NTOK * 256 / 256, 256, 0, stream>>>(sgu, sact);
    k_gemm<<<dim3(D_MODEL / 64, NTOK / 64), 256, 0, stream>>>(sact, 256, ws_down, D_MODEL, sh_out, D_MODEL, 256);
    k_combine<<<NTOK * D_MODEL / 256, 256, 0, stream>>>(contrib, sh_out, ffn);
    k_res_ln<<<NTOK, 256, 0, stream>>>(x1, ffn, nullptr, mod, 5 * D_MODEL, ln2_g, ln2_b, out, 0, 0, nullptr);
}
```

```cpp
#include <hip/hip_runtime.h>
#include <cstdint>
#include <cstdio>

#define D_MODEL 2048
#define SEQ 4096
#define NTOK 8192
#define IN_WIDTH 6144
#define NEXP 256
#define EDIM 256
#define ALPHA_F 1.189207115002721f
#define EPS_F 1e-5f
#define LAS __attribute__((address_space(3)))

#ifndef MK_N_LAUNCHES
#define MK_N_LAUNCHES 1
#endif
constexpr int N_PHASES = 14;
constexpr int LDS_BYTES = 147456;
constexpr int MISC_OFF = 131072 + 320;

#define XB_TMO      128
#define XB_XCNT(j)  (256  + 64 * (j))
#define XB_XSUB(j)  (1280 + 64 * (j))
#define XB_XGEN(j)  (2304 + 64 * (j))
#define XB_TOP      3328
#define XB_TOPGEN   3392
#define XCD_BAR_WORDS 3456
#define XB_SPIN_CAP (1u << 18)
__device__ __forceinline__ unsigned xb_ld(unsigned* p)              { return __hip_atomic_load(p, __ATOMIC_RELAXED, __HIP_MEMORY_SCOPE_AGENT); }
__device__ __forceinline__ unsigned xb_add(unsigned* p, unsigned v) { return __hip_atomic_fetch_add(p, v, __ATOMIC_RELAXED, __HIP_MEMORY_SCOPE_AGENT); }
__device__ __forceinline__ unsigned xb_xcc_id() { return (unsigned)__builtin_amdgcn_s_getreg((3 << 11) | 20) & 0xFu; }
#define XB_SPIN(cond, bar) do { unsigned _sp = 0; while (cond) { __builtin_amdgcn_s_sleep(1); \
    if ((++_sp & 255u) == 0u) { if (xb_ld(&(bar)[XB_TMO])) break; if (_sp > XB_SPIN_CAP) { atomicAdd(&(bar)[XB_TMO], 1u); break; } } } } while (0)
struct XcdBarrier { unsigned* bar; unsigned x; volatile LAS unsigned* st; };
__device__ __forceinline__ XcdBarrier xcd_barrier_post(unsigned* bar, volatile LAS unsigned* st) {
    XcdBarrier b; b.bar = bar; b.x = xb_xcc_id(); b.st = st;
    if (threadIdx.x == 0) (void)xb_add(&bar[XB_XCNT(b.x)], 1u);
    return b;
}
__device__ __forceinline__ void xcd_barrier_complete(unsigned* bar, unsigned x, unsigned& nloc, unsigned& nx) {
    const unsigned G = gridDim.x * gridDim.y * gridDim.z;
    unsigned sum, cnt, mine, sp = 0u;
    for (;;) {
        sum = 0u; cnt = 0u; mine = 0u;
#pragma unroll
        for (unsigned j = 0; j < 16; ++j) { const unsigned c = xb_ld(&bar[XB_XCNT(j)]); sum += c; cnt += (c > 0u) ? 1u : 0u; mine = (j == x) ? c : mine; }
        if (sum == G) break;
        __builtin_amdgcn_s_sleep(1);
        if ((++sp & 255u) == 0u) { if (xb_ld(&bar[XB_TMO])) break; if (sp > XB_SPIN_CAP) { atomicAdd(&bar[XB_TMO], 1u); break; } }
    }
    nloc = mine > 0u ? mine : 1u; nx = cnt > 0u ? cnt : 1u;
}
__device__ __forceinline__ void xcd_barrier(const XcdBarrier& b) {
    asm volatile("s_waitcnt vmcnt(0)" ::: "memory");
    __syncthreads();
    if (threadIdx.x == 0) {
        unsigned* bar = b.bar;
        __builtin_amdgcn_s_waitcnt(0);
        unsigned nloc = b.st[0], nx = b.st[1];
        if (nloc == 0u) { xcd_barrier_complete(bar, b.x, nloc, nx); b.st[0] = nloc; b.st[1] = nx; }
        const unsigned old = xb_add(&bar[XB_XSUB(b.x)], 1u);
        const unsigned gen = old / nloc;
        if (old + 1u == (gen + 1u) * nloc) {
            __builtin_amdgcn_fence(__ATOMIC_RELEASE, "agent");
            asm volatile("s_waitcnt vmcnt(0)" ::: "memory");
            const unsigned og = xb_add(&bar[XB_TOP], 1u);
            const unsigned tg = og / nx;
            if (og + 1u == (tg + 1u) * nx) xb_add(&bar[XB_TOPGEN], 1u);
            else XB_SPIN(xb_ld(&bar[XB_TOPGEN]) == tg, bar);
            __builtin_amdgcn_fence(__ATOMIC_ACQUIRE, "agent");
            xb_add(&bar[XB_XGEN(b.x)], 1u);
            asm volatile("s_waitcnt vmcnt(0)" ::: "memory");
        } else {
            XB_SPIN(xb_ld(&bar[XB_XGEN(b.x)]) == gen, bar);
            __builtin_amdgcn_fence(__ATOMIC_ACQUIRE, "agent");
            asm volatile("s_waitcnt vmcnt(0)" ::: "memory");
        }
    }
    __syncthreads();
}

__device__ __forceinline__ float silu_f(float v) { return v / (1.0f + __expf(-v)); }
__device__ __forceinline__ float sigmoid_f(float v) { return 1.0f / (1.0f + __expf(-v)); }
__device__ __forceinline__ float log_gamma(int h) { return logf(1.0f - exp2f(-5.0f - (float)h)); }

struct Frame {
    LAS unsigned char* lds;
    int tid, vb, vt, nvb;
    const float *x, *c, *w_ada, *b_ada, *w_in, *rel_bias, *attn_gain, *ret_gain, *w_out, *ln1_g, *ln1_b, *w_router, *router_bias, *w_gate, *w_up, *w_down, *ws_gate, *ws_up, *ws_down, *ln2_g, *ln2_b;
    float* out;
    int* counts; float* mod; float* cs; float* h1; float* proj; float* qr; float* kr; float* attn_out; float* U; float* R; float* ycat; float* mixer; float* x1; float* h2;
    float* logits; int* lists; int* a_exp; float* a_w; float* act; float* contrib; float* sgu; float* sact; float* sh_out;
};
#define VB_FOR(u, N) for (int _b = (int)blockIdx.x * 2, u = _b + F.vb; _b < (N); _b += (int)gridDim.x * 2, u = _b + F.vb)

__device__ __forceinline__ void ph_gemm(Frame& F, const float* __restrict__ A, int lda, const float* __restrict__ B, int ldb, float* __restrict__ C, int ldc, int M, int N, int K) {
    LAS float* As = (LAS float*)(F.lds + F.vb * 16384);
    LAS float* Bs = As + 16 * 68;
    const int tid = F.vt, tx = tid & 15, ty = tid >> 4, ntn = N / 64, ntiles = (M / 64) * ntn;
    VB_FOR(u, ntiles) {
        const int m0 = (u / ntn) * 64, n0 = (u % ntn) * 64;
        float acc[4][4];
#pragma unroll
        for (int i = 0; i < 4; ++i)
#pragma unroll
            for (int j = 0; j < 4; ++j) acc[i][j] = 0.f;
        for (int k0 = 0; k0 < K; k0 += 16) {
            {
                const int r = tid >> 2, c4 = (tid & 3) * 4;
                const float4 v = *(const float4*)(A + (size_t)(m0 + r) * lda + k0 + c4);
                As[(c4 + 0) * 68 + r] = v.x; As[(c4 + 1) * 68 + r] = v.y; As[(c4 + 2) * 68 + r] = v.z; As[(c4 + 3) * 68 + r] = v.w;
                const int kr = tid >> 4, cc = (tid & 15) * 4;
                const float4 w = *(const float4*)(B + (size_t)(k0 + kr) * ldb + n0 + cc);
                Bs[kr * 68 + cc + 0] = w.x; Bs[kr * 68 + cc + 1] = w.y; Bs[kr * 68 + cc + 2] = w.z; Bs[kr * 68 + cc + 3] = w.w;
            }
            __syncthreads();
#pragma unroll
            for (int kk = 0; kk < 16; ++kk) {
                float a[4], b[4];
#pragma unroll
                for (int i = 0; i < 4; ++i) a[i] = As[kk * 68 + ty * 4 + i];
#pragma unroll
                for (int j = 0; j < 4; ++j) b[j] = Bs[kk * 68 + tx * 4 + j];
#pragma unroll
                for (int i = 0; i < 4; ++i)
#pragma unroll
                    for (int j = 0; j < 4; ++j) acc[i][j] += a[i] * b[j];
            }
            __syncthreads();
        }
#pragma unroll
        for (int i = 0; i < 4; ++i)
#pragma unroll
            for (int j = 0; j < 4; ++j) C[(size_t)(m0 + ty * 4 + i) * ldc + n0 + tx * 4 + j] = acc[i][j];
    }
}

__device__ __forceinline__ void ph_mod_rope(Frame& F) {
    const int gt = (int)blockIdx.x * 512 + F.tid, GT = (int)gridDim.x * 512;
    for (int i = gt; i < 2 * 6 * D_MODEL; i += GT) {
        const int b = i / (6 * D_MODEL), n = i % (6 * D_MODEL);
        float acc = 0.f;
        for (int k = 0; k < D_MODEL; ++k) acc += silu_f(F.c[b * D_MODEL + k]) * F.w_ada[(size_t)k * (6 * D_MODEL) + n];
        F.mod[i] = acc + F.b_ada[n];
    }
    for (int i = gt; i < SEQ * 32; i += GT) {
        const int s = i >> 5, j = i & 31;
        const float inv = powf(10000.0f, -(float)j / 32.0f);
        const float ang = (float)s * inv;
        F.cs[2 * i] = cosf(ang); F.cs[2 * i + 1] = sinf(ang);
    }
}
__device__ __forceinline__ void ph_modulate(Frame& F) {
    const size_t gt = (size_t)blockIdx.x * 512 + F.tid, GT = (size_t)gridDim.x * 512;
    for (size_t i = gt; i < (size_t)NTOK * D_MODEL; i += GT) {
        const int t = (int)(i / D_MODEL), d = (int)(i % D_MODEL), b = t / SEQ;
        F.h1[i] = F.x[i] * (1.0f + F.mod[b * 6 * D_MODEL + D_MODEL + d]) + F.mod[b * 6 * D_MODEL + d];
    }
}
__device__ __forceinline__ void ph_band_attn(Frame& F) {
    const float* __restrict__ proj = F.proj;
    VB_FOR(u, 1024) {
        const int c = u & 63, h = (u >> 6) & 7, b = u >> 9;
        const int tid = F.vt, i = tid >> 2, part = tid & 3;
        const size_t tq = (size_t)b * SEQ + c * 64 + i;
        float q[32], o[32];
        const float scale = 0.08838834764831845f;
#pragma unroll
        for (int d = 0; d < 32; ++d) { q[d] = proj[tq * IN_WIDTH + h * 128 + part * 32 + d] * scale; o[d] = 0.f; }
        float m = -1e30f, l = 0.f;
        for (int j = 0; j < 576; ++j) {
            const int kpos = c * 64 - 512 + j;
            if (kpos < 0) continue;
            const size_t tk = (size_t)b * SEQ + kpos;
            const float* kp = proj + tk * IN_WIDTH + 1024 + h * 128 + part * 32;
            float s = 0.f;
#pragma unroll
            for (int d = 0; d < 32; ++d) s += q[d] * kp[d];
            s += __shfl_xor(s, 1); s += __shfl_xor(s, 2);
            int dist = 512 + i - j; dist = dist < -63 ? -63 : (dist > 256 ? 256 : dist);
            s += F.rel_bias[h * 320 + dist + 63];
            const float mn = fmaxf(m, s), a = __expf(m - mn), p = __expf(s - mn);
            l = l * a + p; m = mn;
            const float* vp = proj + tk * IN_WIDTH + 2048 + h * 128 + part * 32;
#pragma unroll
            for (int d = 0; d < 32; ++d) o[d] = o[d] * a + p * vp[d];
        }
        const float il = 1.0f / l;
#pragma unroll
        for (int d = 0; d < 32; ++d) F.attn_out[tq * 1024 + h * 128 + part * 32 + d] = o[d] * il;
    }
}
__device__ __forceinline__ void ph_rot(Frame& F) {
    const size_t gt = (size_t)blockIdx.x * 512 + F.tid, GT = (size_t)gridDim.x * 512;
    for (size_t i = gt; i < (size_t)NTOK * 256; i += GT) {
        const int j = (int)(i & 31), h = (int)((i >> 5) & 7); const size_t t = i >> 8; const int s = (int)(t % SEQ);
        const float co = F.cs[(s * 32 + j) * 2], si = F.cs[(s * 32 + j) * 2 + 1];
        const float* pq = F.proj + t * IN_WIDTH + 3072 + h * 64; const float* pk = F.proj + t * IN_WIDTH + 3584 + h * 64;
        const float q1 = pq[j], q2 = pq[j + 32], k1 = pk[j], k2 = pk[j + 32];
        F.qr[t * 512 + h * 64 + j] = q1 * co - q2 * si; F.qr[t * 512 + h * 64 + 32 + j] = q2 * co + q1 * si;
        F.kr[t * 512 + h * 64 + j] = (k1 * co - k2 * si) * 0.125f; F.kr[t * 512 + h * 64 + 32 + j] = (k2 * co + k1 * si) * 0.125f;
    }
}
__device__ __forceinline__ void ph_rms(Frame& F) {
    const int lane = F.tid & 63, gw = (int)blockIdx.x * 8 + (F.tid >> 6), GW = (int)gridDim.x * 8;
    for (int t = gw; t < NTOK; t += GW) {
        float v[16]; float ss = 0.f;
#pragma unroll
        for (int j = 0; j < 16; ++j) { v[j] = F.attn_out[(size_t)t * 1024 + lane + 64 * j]; ss += v[j] * v[j]; }
        for (int o = 32; o > 0; o >>= 1) ss += __shfl_xor(ss, o);
        const float rs = rsqrtf(ss / 1024.0f + EPS_F);
#pragma unroll
        for (int j = 0; j < 16; ++j) F.ycat[(size_t)t * D_MODEL + lane + 64 * j] = v[j] * rs * F.attn_gain[lane + 64 * j];
    }
}
__device__ __forceinline__ void ph_ret_u(Frame& F) {
    VB_FOR(u, 1024) {
        const int c = u & 63, h = (u >> 6) & 7, b = u >> 9, tid = F.vt, kk = tid >> 2, part = tid & 3;
        const float lg = log_gamma(h);
        float acc[32];
#pragma unroll
        for (int d = 0; d < 32; ++d) acc[d] = 0.f;
        for (int m = 0; m < 64; ++m) {
            const size_t t = (size_t)b * SEQ + c * 64 + m;
            const float kv = F.kr[t * 512 + h * 64 + kk] * __expf(lg * (float)(63 - m));
            const float* vp = F.proj + t * IN_WIDTH + 4096 + h * 128 + part * 32;
#pragma unroll
            for (int d = 0; d < 32; ++d) acc[d] += kv * vp[d];
        }
        float* up = F.U + ((((size_t)b * 8 + h) * 64 + c) * 64 + kk) * 128 + part * 32;
#pragma unroll
        for (int d = 0; d < 32; ++d) up[d] = acc[d];
    }
}
__device__ __forceinline__ void ph_ret_scan(Frame& F) {
    const int gt = (int)blockIdx.x * 512 + F.tid, GT = (int)gridDim.x * 512;
    for (int i = gt; i < 2 * 8 * 8192; i += GT) {
        const int e = i & 8191, bh = i >> 13, h = bh & 7;
        const float g = __expf(log_gamma(h) * 64.0f);
        float st = 0.f;
        for (int c = 0; c < 64; ++c) { const size_t o = ((size_t)bh * 64 + c) * 8192 + e; F.R[o] = st; st = g * st + F.U[o]; }
    }
}
__device__ __forceinline__ void ph_ret_out(Frame& F) {
    VB_FOR(u, 1024) {
        const int c = u & 63, h = (u >> 6) & 7, b = u >> 9, tid = F.vt, n = tid >> 2, part = tid & 3;
        const float lg = log_gamma(h);
        const size_t tn = (size_t)b * SEQ + c * 64 + n;
        float q[16], o[32];
#pragma unroll
        for (int d = 0; d < 16; ++d) q[d] = F.qr[tn * 512 + h * 64 + part * 16 + d];
#pragma unroll
        for (int d = 0; d < 32; ++d) o[d] = 0.f;
        for (int m = 0; m < 64; ++m) {
            const size_t tm = (size_t)b * SEQ + c * 64 + m;
            const float* kp = F.kr + tm * 512 + h * 64 + part * 16;
            float s = 0.f;
#pragma unroll
            for (int d = 0; d < 16; ++d) s += q[d] * kp[d];
            s += __shfl_xor(s, 1); s += __shfl_xor(s, 2);
            const int dd = n > m ? n - m : m - n;
            s *= __expf(lg * (float)dd);
            const float* vp = F.proj + tm * IN_WIDTH + 4096 + h * 128 + part * 32;
#pragma unroll
            for (int d = 0; d < 32; ++d) o[d] += s * vp[d];
        }
        const float xi = __expf(lg * (float)(n + 1));
        const float* Rp = F.R + (((size_t)b * 8 + h) * 64 + c) * 8192;
        for (int kk = 0; kk < 64; ++kk) {
            const float qv = F.qr[tn * 512 + h * 64 + kk] * xi;
            const float* rp = Rp + kk * 128 + part * 32;
#pragma unroll
            for (int d = 0; d < 32; ++d) o[d] += qv * rp[d];
        }
        float s1 = 0.f;
#pragma unroll
        for (int d = 0; d < 32; ++d) s1 += o[d];
        s1 += __shfl_xor(s1, 1); s1 += __shfl_xor(s1, 2);
        const float mu = s1 / 128.0f; float s2 = 0.f;
#pragma unroll
        for (int d = 0; d < 32; ++d) { const float dv = o[d] - mu; s2 += dv * dv; }
        s2 += __shfl_xor(s2, 1); s2 += __shfl_xor(s2, 2);
        const float rs = rsqrtf(s2 / 128.0f + EPS_F);
#pragma unroll
        for (int d = 0; d < 32; ++d) {
            const int col = h * 128 + part * 32 + d;
            const float gb = F.proj[tn * IN_WIDTH + 5120 + col];
            F.ycat[tn * D_MODEL + 1024 + col] = silu_f(gb) * (o[d] - mu) * rs * F.ret_gain[col];
        }
    }
}
__device__ __forceinline__ void ph_res_ln(Frame& F, const float* __restrict__ xres, const float* __restrict__ y, const float* __restrict__ contrib, int g_off,
                                          const float* __restrict__ gain, const float* __restrict__ bias, float* __restrict__ xo, int sh_off, int sc_off, float* __restrict__ hmod) {
    const int lane = F.tid & 63, gw = (int)blockIdx.x * 8 + (F.tid >> 6), GW = (int)gridDim.x * 8;
    for (int t = gw; t < NTOK; t += GW) {
        const int b = t / SEQ;
        float z[32]; float s = 0.f;
#pragma unroll
        for (int j = 0; j < 32; ++j) {
            const int d = lane + 64 * j; float yy = y[(size_t)t * D_MODEL + d];
            if (contrib) {
#pragma unroll
                for (int k = 0; k < 8; ++k) yy += contrib[((size_t)t * 8 + k) * D_MODEL + d];
            }
            z[j] = ALPHA_F * xres[(size_t)t * D_MODEL + d] + F.mod[b * 6 * D_MODEL + g_off + d] * yy; s += z[j];
        }
        for (int o = 32; o > 0; o >>= 1) s += __shfl_xor(s, o);
        const float mu = s / (float)D_MODEL; float q = 0.f;
#pragma unroll
        for (int j = 0; j < 32; ++j) { const float dv = z[j] - mu; q += dv * dv; }
        for (int o = 32; o > 0; o >>= 1) q += __shfl_xor(q, o);
        const float rs = rsqrtf(q / (float)D_MODEL + EPS_F);
#pragma unroll
        for (int j = 0; j < 32; ++j) {
            const int d = lane + 64 * j; const float v = (z[j] - mu) * rs * gain[d] + bias[d];
            xo[(size_t)t * D_MODEL + d] = v;
            if (hmod) hmod[(size_t)t * D_MODEL + d] = v * (1.0f + F.mod[b * 6 * D_MODEL + sc_off + d]) + F.mod[b * 6 * D_MODEL + sh_off + d];
        }
    }
}
__device__ __forceinline__ void ph_route(Frame& F) {
    LAS float* sb = (LAS float*)(F.lds + F.vb * 4096); LAS float* ssc = sb + 256; LAS float* gs = ssc + 256; LAS int* gsel = (LAS int*)(gs + 8); LAS int* pick = gsel + 8;
    const int e = F.vt;
    VB_FOR(t, NTOK) {
        const float sc = sigmoid_f(F.logits[(size_t)t * NEXP + e]); const float bi = sc + F.router_bias[e];
        __syncthreads();
        ssc[e] = sc; sb[e] = bi;
        __syncthreads();
        if (e < 8) { float t1 = -1e30f, t2 = -1e30f; for (int i = 0; i < 32; ++i) { const float v = sb[e * 32 + i]; if (v > t1) { t2 = t1; t1 = v; } else if (v > t2) t2 = v; } gs[e] = t1 + t2; gsel[e] = 0; }
        __syncthreads();
        if (e == 0) {
            for (int r = 0; r < 4; ++r) { int bi_ = 0; float bv = -1e30f; for (int g = 0; g < 8; ++g) if (!gsel[g] && gs[g] > bv) { bv = gs[g]; bi_ = g; } gsel[bi_] = 1; }
        }
        __syncthreads();
        if (!gsel[e >> 5]) sb[e] = -1e30f;
        __syncthreads();
        if (e == 0) {
            float wsum = 0.f;
            for (int r = 0; r < 8; ++r) { int bi_ = 0; float bv = -2e30f; for (int i = 0; i < 256; ++i) if (sb[i] > bv) { bv = sb[i]; bi_ = i; } pick[r] = bi_; sb[bi_] = -3e30f; wsum += ssc[bi_]; }
            for (int r = 0; r < 8; ++r) {
                const int ex = pick[r]; const int slot = atomicAdd(&F.counts[ex], 1);
                F.lists[ex * NTOK + slot] = t * 8 + r; F.a_exp[t * 8 + r] = ex; F.a_w[t * 8 + r] = ssc[ex] / wsum * 2.5f;
            }
        }
    }
}
__device__ __forceinline__ void ph_swiglu_act(Frame& F) {
    const size_t gt = (size_t)blockIdx.x * 512 + F.tid, GT = (size_t)gridDim.x * 512;
    for (size_t i = gt; i < (size_t)NTOK * 256; i += GT) { const size_t t = i >> 8; const int j = (int)(i & 255); F.sact[i] = silu_f(F.sgu[t * 512 + j]) * F.sgu[t * 512 + 256 + j]; }
}
__device__ __forceinline__ void ph_moe_gu(Frame& F) {
    LAS float* hs = (LAS float*)(F.lds + F.vb * 8192);
    const int j = F.vt;
    for (int e = blockIdx.x; e < NEXP; e += gridDim.x) {
        const int cnt = F.counts[e];
        const float* wgp = F.w_gate + (size_t)e * D_MODEL * EDIM; const float* wup = F.w_up + (size_t)e * D_MODEL * EDIM;
        for (int t0 = 0; t0 < cnt; t0 += 16) {
            const int tile0 = t0 + F.vb * 8;
            int aid[8];
#pragma unroll
            for (int i = 0; i < 8; ++i) { const int s = tile0 + i; aid[i] = s < cnt ? F.lists[e * NTOK + s] : -1; }
            float ag[8], au[8];
#pragma unroll
            for (int i = 0; i < 8; ++i) { ag[i] = 0.f; au[i] = 0.f; }
            for (int k0 = 0; k0 < D_MODEL; k0 += 256) {
                __syncthreads();
#pragma unroll
                for (int i = 0; i < 8; ++i) hs[i * 256 + j] = aid[i] >= 0 ? F.h2[(size_t)(aid[i] >> 3) * D_MODEL + k0 + j] : 0.f;
                __syncthreads();
                for (int kk = 0; kk < 256; ++kk) {
                    const float a = wgp[(size_t)(k0 + kk) * EDIM + j], u = wup[(size_t)(k0 + kk) * EDIM + j];
#pragma unroll
                    for (int i = 0; i < 8; ++i) { const float hv = hs[i * 256 + kk]; ag[i] += hv * a; au[i] += hv * u; }
                }
            }
#pragma unroll
            for (int i = 0; i < 8; ++i) if (aid[i] >= 0) F.act[(size_t)aid[i] * EDIM + j] = silu_f(ag[i]) * au[i];
        }
    }
}
__device__ __forceinline__ void ph_moe_down(Frame& F) {
    LAS float* as = (LAS float*)(F.lds + F.vb * 8192);
    const int j = F.vt;
    for (int e = blockIdx.x; e < NEXP; e += gridDim.x) {
        const int cnt = F.counts[e];
        for (int t0 = 0; t0 < cnt; t0 += 16) {
            const int tile0 = t0 + F.vb * 8;
            int aid[8];
#pragma unroll
            for (int i = 0; i < 8; ++i) { const int s = tile0 + i; aid[i] = s < cnt ? F.lists[e * NTOK + s] : -1; }
            __syncthreads();
#pragma unroll
            for (int i = 0; i < 8; ++i) as[i * 256 + j] = aid[i] >= 0 ? F.act[(size_t)aid[i] * EDIM + j] : 0.f;
            __syncthreads();
            for (int half = 0; half < 2; ++half) {
                float acc[4][8];
#pragma unroll
                for (int c = 0; c < 4; ++c)
#pragma unroll
                    for (int i = 0; i < 8; ++i) acc[c][i] = 0.f;
                const float* wp = F.w_down + (size_t)e * EDIM * D_MODEL + half * 1024 + j;
                for (int kk = 0; kk < 256; ++kk) {
                    float w[4];
#pragma unroll
                    for (int c = 0; c < 4; ++c) w[c] = wp[(size_t)kk * D_MODEL + 256 * c];
#pragma unroll
                    for (int i = 0; i < 8; ++i) { const float a = as[i * 256 + kk];
#pragma unroll
                        for (int c = 0; c < 4; ++c) acc[c][i] += a * w[c]; }
                }
#pragma unroll
                for (int i = 0; i < 8; ++i) if (aid[i] >= 0) { const float rw = F.a_w[aid[i]];
#pragma unroll
                    for (int c = 0; c < 4; ++c) F.contrib[(size_t)aid[i] * D_MODEL + half * 1024 + j + 256 * c] = rw * acc[c][i]; }
            }
        }
    }
}

struct Args { const float* in[21]; float* out; unsigned char* ws; int ph_lo, ph_hi, li, pad; };
constexpr size_t WS_CTL_BYTES = 65536;

__global__ void __launch_bounds__(512, 2) mk_fwd(Args a) {
    extern __shared__ __attribute__((aligned(16))) unsigned char lds_raw[];
    Frame F;
    F.lds = (LAS unsigned char*)lds_raw;
    F.tid = threadIdx.x; F.vb = F.tid >> 8; F.vt = F.tid & 255; F.nvb = gridDim.x * 2;
    F.x = a.in[0]; F.c = a.in[1]; F.w_ada = a.in[2]; F.b_ada = a.in[3]; F.w_in = a.in[4]; F.rel_bias = a.in[5]; F.attn_gain = a.in[6]; F.ret_gain = a.in[7]; F.w_out = a.in[8];
    F.ln1_g = a.in[9]; F.ln1_b = a.in[10]; F.w_router = a.in[11]; F.router_bias = a.in[12]; F.w_gate = a.in[13]; F.w_up = a.in[14]; F.w_down = a.in[15]; F.ws_gate = a.in[16];
    F.ws_up = a.in[17]; F.ws_down = a.in[18]; F.ln2_g = a.in[19]; F.ln2_b = a.in[20]; F.out = a.out;
    {
        unsigned char* w = a.ws; size_t off = WS_CTL_BYTES;
#define CARVE(T, name, bytes) name = (T*)(w + off); off += (((size_t)(bytes)) + 255) & ~(size_t)255
        F.counts = (int*)(w + 61440);
        CARVE(float, F.mod, 2 * 6 * D_MODEL * 4); CARVE(float, F.cs, SEQ * 32 * 2 * 4); CARVE(float, F.h1, (size_t)NTOK * D_MODEL * 4); CARVE(float, F.proj, (size_t)NTOK * IN_WIDTH * 4);
        CARVE(float, F.qr, (size_t)NTOK * 512 * 4); CARVE(float, F.kr, (size_t)NTOK * 512 * 4); CARVE(float, F.attn_out, (size_t)NTOK * 1024 * 4);
        CARVE(float, F.U, (size_t)2 * 8 * 64 * 8192 * 4); CARVE(float, F.R, (size_t)2 * 8 * 64 * 8192 * 4); CARVE(float, F.ycat, (size_t)NTOK * D_MODEL * 4);
        CARVE(float, F.mixer, (size_t)NTOK * D_MODEL * 4); CARVE(float, F.x1, (size_t)NTOK * D_MODEL * 4); CARVE(float, F.h2, (size_t)NTOK * D_MODEL * 4);
        CARVE(float, F.logits, (size_t)NTOK * NEXP * 4); CARVE(int, F.lists, (size_t)NEXP * NTOK * 4); CARVE(int, F.a_exp, (size_t)NTOK * 8 * 4); CARVE(float, F.a_w, (size_t)NTOK * 8 * 4);
        CARVE(float, F.act, (size_t)NTOK * 8 * EDIM * 4); CARVE(float, F.contrib, (size_t)NTOK * 8 * D_MODEL * 4); CARVE(float, F.sgu, (size_t)NTOK * 512 * 4);
        CARVE(float, F.sact, (size_t)NTOK * 256 * 4); CARVE(float, F.sh_out, (size_t)NTOK * D_MODEL * 4);
#undef CARVE
    }
    for (int u = F.tid; u < (LDS_BYTES - 131072) / 4; u += 512) ((LAS unsigned*)(F.lds + 131072))[u] = 0u;
    __syncthreads();
    volatile LAS unsigned* MISC = (volatile LAS unsigned*)(F.lds + MISC_OFF);
    XcdBarrier bar = xcd_barrier_post((unsigned*)a.ws + a.li * 4096, MISC + 8);
    const int lo = a.ph_lo, hi = a.ph_hi;
#define IN(k) (lo <= (k) && (k) < hi)
#define SEAM(k) do { if (IN(k) && IN((k) + 1)) xcd_barrier(bar); } while (0)
    if (IN(0)) { ph_mod_rope(F); } SEAM(0);
    if (IN(1)) { ph_modulate(F); } SEAM(1);
    if (IN(2)) { ph_gemm(F, F.h1, D_MODEL, F.w_in, IN_WIDTH, F.proj, IN_WIDTH, NTOK, IN_WIDTH, D_MODEL); } SEAM(2);
    if (IN(3)) { ph_band_attn(F); ph_rot(F); } SEAM(3);
    if (IN(4)) { ph_rms(F); ph_ret_u(F); } SEAM(4);
    if (IN(5)) { ph_ret_scan(F); } SEAM(5);
    if (IN(6)) { ph_ret_out(F); } SEAM(6);
    if (IN(7)) { ph_gemm(F, F.ycat, D_MODEL, F.w_out, D_MODEL, F.mixer, D_MODEL, NTOK, D_MODEL, D_MODEL); } SEAM(7);
    if (IN(8)) { ph_res_ln(F, F.x, F.mixer, nullptr, 2 * D_MODEL, F.ln1_g, F.ln1_b, F.x1, 3 * D_MODEL, 4 * D_MODEL, F.h2); } SEAM(8);
    if (IN(9)) { ph_gemm(F, F.h2, D_MODEL, F.w_router, NEXP, F.logits, NEXP, NTOK, NEXP, D_MODEL);
                 ph_gemm(F, F.h2, D_MODEL, F.ws_gate, 256, F.sgu, 512, NTOK, 256, D_MODEL);
                 ph_gemm(F, F.h2, D_MODEL, F.ws_up, 256, F.sgu + 256, 512, NTOK, 256, D_MODEL); } SEAM(9);
    if (IN(10)) { ph_route(F); ph_swiglu_act(F); } SEAM(10);
    if (IN(11)) { ph_moe_gu(F); __syncthreads(); ph_gemm(F, F.sact, 256, F.ws_down, D_MODEL, F.sh_out, D_MODEL, NTOK, D_MODEL, 256); } SEAM(11);
    if (IN(12)) { ph_moe_down(F); } SEAM(12);
    if (IN(13)) { ph_res_ln(F, F.x1, F.sh_out, F.contrib, 5 * D_MODEL, F.ln2_g, F.ln2_b, F.out, 0, 0, nullptr); }
#undef IN
#undef SEAM
}

extern "C" void kernel_launch(void* const* d_in, const int* in_sizes, int n_in, void* d_out, int out_size, void* d_ws, size_t ws_size, hipStream_t stream) {
    static int grid = 0;
    if (grid == 0) {
        int dev = 0, cus = 0, per_cu = 0;
        if (hipGetDevice(&dev) != hipSuccess || hipDeviceGetAttribute(&cus, hipDeviceAttributeMultiprocessorCount, dev) != hipSuccess) { fprintf(stderr, "kernel_launch: device query failed\n"); grid = -1; return; }
        if (hipFuncSetAttribute((const void*)mk_fwd, hipFuncAttributeMaxDynamicSharedMemorySize, LDS_BYTES) != hipSuccess) { fprintf(stderr, "kernel_launch: hipFuncSetAttribute failed\n"); grid = -1; return; }
        if (hipOccupancyMaxActiveBlocksPerMultiprocessor(&per_cu, (const void*)mk_fwd, 512, LDS_BYTES) != hipSuccess || per_cu < 1)
            fprintf(stderr, "kernel_launch: occupancy query reports %d workgroups per CU\n", per_cu);
        (void)hipGetLastError();
        grid = cus;
    }
    if (grid < 0) return;
    if (hipMemsetAsync(d_ws, 0, WS_CTL_BYTES, stream) != hipSuccess) { fprintf(stderr, "kernel_launch: memset failed\n"); return; }
    Args a{};
    for (int i = 0; i < 21; ++i) a.in[i] = (const float*)d_in[i];
    a.out = (float*)d_out; a.ws = (unsigned char*)d_ws;
    for (int li = 0; li < MK_N_LAUNCHES; ++li) {
        a.ph_lo = li * N_PHASES / MK_N_LAUNCHES; a.ph_hi = (li + 1) * N_PHASES / MK_N_LAUNCHES; a.li = li;
        hipLaunchKernelGGL(mk_fwd, dim3(grid), dim3(512), LDS_BYTES, stream, a);
        const hipError_t le = hipPeekAtLastError();
        if (le != hipSuccess) { fprintf(stderr, "kernel_launch: launch %d failed: %s\n", li, hipGetErrorName(le)); break; }
    }
}
```

```cpp
#include <hip/hip_runtime.h>
#include <cstdint>
#include <cstdio>

#define D_MODEL 2048
#define SEQ 4096
#define NTOK 8192
#define IN_WIDTH 6144
#define NEXP 256
#define EDIM 256
#define ALPHA_F 1.189207115002721f
#define EPS_F 1e-5f
#define LAS __attribute__((address_space(3)))

#ifndef MK_N_LAUNCHES
#define MK_N_LAUNCHES 1
#endif
constexpr int N_PHASES = 14;
constexpr int LDS_BYTES = 147456;
constexpr int MISC_OFF = 131072 + 320;

#define XB_TMO      128
#define XB_XCNT(j)  (256  + 64 * (j))
#define XB_XSUB(j)  (1280 + 64 * (j))
#define XB_XGEN(j)  (2304 + 64 * (j))
#define XB_TOP      3328
#define XB_TOPGEN   3392
#define XCD_BAR_WORDS 3456
#define XB_SPIN_CAP (1u << 18)
__device__ __forceinline__ unsigned xb_ld(unsigned* p)              { return __hip_atomic_load(p, __ATOMIC_RELAXED, __HIP_MEMORY_SCOPE_AGENT); }
__device__ __forceinline__ unsigned xb_add(unsigned* p, unsigned v) { return __hip_atomic_fetch_add(p, v, __ATOMIC_RELAXED, __HIP_MEMORY_SCOPE_AGENT); }
__device__ __forceinline__ unsigned xb_xcc_id() { return (unsigned)__builtin_amdgcn_s_getreg((3 << 11) | 20) & 0xFu; }
#define XB_SPIN(cond, bar) do { unsigned _sp = 0; while (cond) { __builtin_amdgcn_s_sleep(1); \
    if ((++_sp & 255u) == 0u) { if (xb_ld(&(bar)[XB_TMO])) break; if (_sp > XB_SPIN_CAP) { atomicAdd(&(bar)[XB_TMO], 1u); break; } } } } while (0)
struct XcdBarrier { unsigned* bar; unsigned x; volatile LAS unsigned* st; };
__device__ __forceinline__ XcdBarrier xcd_barrier_post(unsigned* bar, volatile LAS unsigned* st) {
    XcdBarrier b; b.bar = bar; b.x = xb_xcc_id(); b.st = st;
    if (threadIdx.x == 0) (void)xb_add(&bar[XB_XCNT(b.x)], 1u);
    return b;
}
__device__ __forceinline__ void xcd_barrier_complete(unsigned* bar, unsigned x, unsigned& nloc, unsigned& nx) {
    const unsigned G = gridDim.x * gridDim.y * gridDim.z;
    unsigned sum, cnt, mine, sp = 0u;
    for (;;) {
        sum = 0u; cnt = 0u; mine = 0u;
#pragma unroll
        for (unsigned j = 0; j < 16; ++j) { const unsigned c = xb_ld(&bar[XB_XCNT(j)]); sum += c; cnt += (c > 0u) ? 1u : 0u; mine = (j == x) ? c : mine; }
        if (sum == G) break;
        __builtin_amdgcn_s_sleep(1);
        if ((++sp & 255u) == 0u) { if (xb_ld(&bar[XB_TMO])) break; if (sp > XB_SPIN_CAP) { atomicAdd(&bar[XB_TMO], 1u); break; } }
    }
    nloc = mine > 0u ? mine : 1u; nx = cnt > 0u ? cnt : 1u;
}
__device__ __forceinline__ void xcd_barrier(const XcdBarrier& b) {
    asm volatile("s_waitcnt vmcnt(0)" ::: "memory");
    __syncthreads();
    if (threadIdx.x == 0) {
        unsigned* bar = b.bar;
        __builtin_amdgcn_s_waitcnt(0);
        unsigned nloc = b.st[0], nx = b.st[1];
        if (nloc == 0u) { xcd_barrier_complete(bar, b.x, nloc, nx); b.st[0] = nloc; b.st[1] = nx; }
        const unsigned old = xb_add(&bar[XB_XSUB(b.x)], 1u);
        const unsigned gen = old / nloc;
        if (old + 1u == (gen + 1u) * nloc) {
            __builtin_amdgcn_fence(__ATOMIC_RELEASE, "agent");
            asm volatile("s_waitcnt vmcnt(0)" ::: "memory");
            const unsigned og = xb_add(&bar[XB_TOP], 1u);
            const unsigned tg = og / nx;
            if (og + 1u == (tg + 1u) * nx) xb_add(&bar[XB_TOPGEN], 1u);
            else XB_SPIN(xb_ld(&bar[XB_TOPGEN]) == tg, bar);
            __builtin_amdgcn_fence(__ATOMIC_ACQUIRE, "agent");
            xb_add(&bar[XB_XGEN(b.x)], 1u);
            asm volatile("s_waitcnt vmcnt(0)" ::: "memory");
        } else {
            XB_SPIN(xb_ld(&bar[XB_XGEN(b.x)]) == gen, bar);
            __builtin_amdgcn_fence(__ATOMIC_ACQUIRE, "agent");
            asm volatile("s_waitcnt vmcnt(0)" ::: "memory");
        }
    }
    __syncthreads();
}

__device__ __forceinline__ float silu_f(float v) { return v / (1.0f + __expf(-v)); }
__device__ __forceinline__ float sigmoid_f(float v) { return 1.0f / (1.0f + __expf(-v)); }
__device__ __forceinline__ float log_gamma(int h) { return logf(1.0f - exp2f(-5.0f - (float)h)); }

namespace pg8 {
#define PG8_LAS __attribute__((address_space(3)))
typedef unsigned short bf16_t;
typedef short bf16x8 __attribute__((ext_vector_type(8)));
typedef float f32x4 __attribute__((ext_vector_type(4)));
typedef unsigned u32x4 __attribute__((ext_vector_type(4)));
constexpr int BM = 256, BK = 64, HALF = 128, HTB = HALF * BK * 2  , STAGE_BYTES = 8 * HTB, NXCD = 8, WGM = 8;

__host__ __device__ __forceinline__ int lds_byte(int r, int c) { const int st = (r >> 4) * 2 + (c >> 5), rr = r & 15, cc = c & 31, ob = rr * 64 + cc * 2; return st * 1024 + (ob ^ (((ob >> 9) & 1) << 5)); }
__host__ __device__ __forceinline__ void stage_rc(int b, int& R, int& C) { const int st = b / 1024, sb = b % 1024, swz = sb ^ (((sb >> 9) & 1) << 5); R = (st >> 1) * 16 + swz / 64; C = (st & 1) * 32 + (swz % 64) / 2; }
__host__ __device__ __forceinline__ int perm32(int rho) { const int n = rho >> 4, i = rho & 15; return 8 * (i >> 2) + 4 * n + (i & 3); }

struct Unit { int pm, pn; };
struct Gemm { const bf16_t* A; const bf16_t* Bt; int M, N, K; };

struct StaticOrder {
    int nM, nN, nwg, G, c;
    __host__ __device__ void init(int M, int N, int G_, int c_) { nM = M / BM; nN = N / BM; nwg = nM * nN; G = G_; c = c_; }
    __host__ __device__ bool next(int i, Unit& u) const {
        const long L = (long)i * G + c; if (L >= nwg) return false;
        int wgid = (int)L; { const int q = nwg / NXCD, r = nwg % NXCD, xcd = wgid % NXCD, off = wgid / NXCD; wgid = (xcd < r ? xcd * (q + 1) : r * (q + 1) + (xcd - r) * q) + off; }
        const int nig = WGM * nN, gid = wgid / nig, fm = gid * WGM, gsz = (nM - fm) < WGM ? (nM - fm) : WGM;
        u.pm = fm + ((wgid % nig) % gsz); u.pn = (wgid % nig) / gsz; return true;
    }
    __device__ __forceinline__ void a_ready(const Unit&) const {}
    __device__ __forceinline__ void done(const Unit&) const {}
};

__device__ __forceinline__ unsigned cvt_pk_bf16(float lo, float hi) { unsigned r; asm volatile("v_cvt_pk_bf16_f32 %0, %1, %2" : "=v"(r) : "v"(lo), "v"(hi)); return r; }
struct EpiF32 {
    static constexpr bool PERM = true, AFTER_DRAIN = false, MIDK = false;
    float* C; int ldc; int midk_tile;
    __device__ __forceinline__ void midscale(f32x4 (&acc)[2][2][4][2], const Unit& u, int wr, int wc, int fr, int fq) const {}
    __device__ __forceinline__ void operator()(const f32x4 (&acc)[2][2][4][2], const Unit& u, int wr, int wc, int fr, int fq) const {
        const int row0 = u.pm * BM + wr * 64 + fr, col0 = u.pn * BM + wc * 32 + 8 * fq;
#pragma unroll
        for (int ai = 0; ai < 2; ++ai)
#pragma unroll
            for (int m = 0; m < 4; ++m) { float* rowp = C + (size_t)(row0 + ai * HALF + m * 16) * ldc + col0;
#pragma unroll
                for (int bj = 0; bj < 2; ++bj) { *(f32x4*)(rowp + bj * HALF) = acc[ai][bj][m][0]; *(f32x4*)(rowp + bj * HALF + 4) = acc[ai][bj][m][1]; } }
    }
};
template <class Epi, class Sched, bool ALIGN_EPI = false, bool SP2 = false>
__device__ __forceinline__ void gemm_phase(PG8_LAS unsigned char* lds, const Gemm g, const Sched& S, const Epi& E) {
    const int tid = threadIdx.x, wid = __builtin_amdgcn_readfirstlane(tid >> 6), lane = tid & 63, wr = wid >> 2, wc = wid & 3, fr = lane & 15, fq = lane >> 4;
    const int K = g.K, nt = K / BK;
    unsigned voffA[2], voffB[2];
#pragma unroll
    for (int i = 0; i < 2; ++i) { int R, C; stage_rc(tid * 16 + i * 8192, R, C); const int Rb = Epi::PERM ? ((R & ~31) + perm32(R & 31)) : R;
        voffA[i] = (unsigned)(R * K + C) * 2u; voffB[i] = (unsigned)(Rb * K + C) * 2u; }
    const size_t kstep = (size_t)(BK * 2);
    const size_t hstep = (size_t)HALF * K * 2;
    const size_t tstep = 2 * hstep;
    const unsigned ldsw = (unsigned)wid * 1024u;
    const int aoff = lds_byte(wr * 64 + fr, fq * 8), boff = lds_byte(wc * 32 + fr, fq * 8);
#define PG8_SA(b, h) (((b) * 2 + (h)) * HTB)
#define PG8_SB(b, h) ((4 + (b) * 2 + (h)) * HTB)
#define PG8_STAGE(bufoff, gbase, voff) do { _Pragma("unroll") for (int _i = 0; _i < 2; ++_i) \
        __builtin_amdgcn_global_load_lds((const unsigned*)((const char*)(gbase) + (voff)[_i]), (PG8_LAS unsigned*)(lds + (bufoff) + ldsw + _i * 8192), 16, 0, 0); } while (0)
#define PG8_LDA(dst, b, h) do { _Pragma("unroll") for (int m = 0; m < 4; ++m) _Pragma("unroll") for (int k = 0; k < 2; ++k) dst[m][k] = *(const PG8_LAS bf16x8*)(lds + PG8_SA(b, h) + aoff + m * 2048 + k * 1024); } while (0)
#define PG8_LDB(dst, b, h) do { _Pragma("unroll") for (int n = 0; n < 2; ++n) _Pragma("unroll") for (int k = 0; k < 2; ++k) dst[n][k] = *(const PG8_LAS bf16x8*)(lds + PG8_SB(b, h) + boff + n * 2048 + k * 1024); } while (0)
#define PG8_MMA(ai, bj, At, Bt) do { __builtin_amdgcn_s_setprio(1); _Pragma("unroll") for (int m = 0; m < 4; ++m) _Pragma("unroll") for (int n = 0; n < 2; ++n) _Pragma("unroll") for (int k = 0; k < 2; ++k) \
        acc[ai][bj][m][n] = __builtin_amdgcn_mfma_f32_16x16x32_bf16(Bt[n][k], At[m][k], acc[ai][bj][m][n], 0, 0, 0); __builtin_amdgcn_s_setprio(0); } while (0)
#define PG8_WAIT_V(n) asm volatile("s_waitcnt vmcnt(" #n ")" ::: "memory")
#define PG8_WAIT_L(n) asm volatile("s_waitcnt lgkmcnt(" #n ")" ::: "memory")
#define PG8_BAR __builtin_amdgcn_s_barrier()
#define PG8_SCHED __builtin_amdgcn_sched_barrier(0)
    Unit cur, nxt; int ui = 0;
    if (!S.next(0, cur)) return;
    f32x4 acc[2][2][4][2];
#pragma unroll
    for (int a = 0; a < 2; ++a)
#pragma unroll
        for (int b = 0; b < 2; ++b)
#pragma unroll
            for (int m = 0; m < 4; ++m)
#pragma unroll
                for (int n = 0; n < 2; ++n) acc[a][b][m][n] = (f32x4){0.f, 0.f, 0.f, 0.f};
    bf16x8 At[4][2], B0[2][2], B1[2][2];
    const char* cA = (const char*)g.A + (size_t)cur.pm * tstep; const char* cB = (const char*)g.Bt + (size_t)cur.pn * tstep;
    S.a_ready(cur);
    if constexpr (SP2) {
        PG8_STAGE(PG8_SB(0, 0), cB, voffB); PG8_STAGE(PG8_SB(0, 1), cB + hstep, voffB); PG8_STAGE(PG8_SA(0, 0), cA, voffA); PG8_STAGE(PG8_SA(0, 1), cA + hstep, voffA);
        if (wr == 1) PG8_BAR;
        PG8_WAIT_V(2); PG8_BAR;
        PG8_STAGE(PG8_SB(1, 0), cB + kstep, voffB); PG8_STAGE(PG8_SA(1, 0), cA + kstep, voffA); PG8_STAGE(PG8_SB(1, 1), cB + hstep + kstep, voffB);
        PG8_WAIT_V(6); PG8_BAR;
    } else {
        PG8_STAGE(PG8_SB(0, 0), cB, voffB); PG8_STAGE(PG8_SA(0, 0), cA, voffA); PG8_STAGE(PG8_SB(0, 1), cB + hstep, voffB); PG8_STAGE(PG8_SA(0, 1), cA + hstep, voffA);
        if (wr == 1) PG8_BAR;
        PG8_WAIT_V(4); PG8_BAR;
        PG8_STAGE(PG8_SB(1, 0), cB + kstep, voffB); PG8_STAGE(PG8_SA(1, 0), cA + kstep, voffA); PG8_STAGE(PG8_SB(1, 1), cB + hstep + kstep, voffB);
        PG8_WAIT_V(6); PG8_BAR;
    }
    for (;;) {
        const bool has_next = S.next(ui + 1, nxt);
        const char* nA = has_next ? (const char*)g.A + (size_t)nxt.pm * tstep : cA; const char* nB = has_next ? (const char*)g.Bt + (size_t)nxt.pn * tstep : cB;
        for (int t = 0; t < nt; t += 2) {
            const bool last = (t == nt - 2);
            if constexpr (Epi::MIDK) { if (t == E.midk_tile) E.midscale(acc, cur, wr, wc, fr, fq); }
            const char* a1 = cA + (size_t)(t + 1) * kstep;
            const char* a2 = last ? nA : cA + (size_t)(t + 2) * kstep; const char* b2 = last ? nB : cB + (size_t)(t + 2) * kstep;
            const char* a3 = a2 + kstep; const char* b3 = b2 + kstep;
            if (last && has_next) S.a_ready(nxt);
            if constexpr (SP2) {
            PG8_LDB(B0, 0, 0); PG8_LDB(B1, 0, 1); PG8_SCHED; PG8_LDA(At, 0, 0); PG8_STAGE(PG8_SA(1, 1), a1 + hstep, voffA);
            PG8_WAIT_V(8); PG8_WAIT_L(0); PG8_BAR; PG8_MMA(0, 0, At, B0); PG8_MMA(0, 1, At, B1); PG8_BAR; PG8_SCHED;
            PG8_LDA(At, 0, 1); PG8_STAGE(PG8_SB(0, 0), b2, voffB); PG8_STAGE(PG8_SB(0, 1), b2 + hstep, voffB); PG8_STAGE(PG8_SA(0, 0), a2, voffA);
            PG8_WAIT_V(8); PG8_WAIT_L(0); PG8_BAR; PG8_MMA(1, 0, At, B0); PG8_MMA(1, 1, At, B1); PG8_BAR; PG8_SCHED;
            PG8_LDB(B0, 1, 0); PG8_LDB(B1, 1, 1); PG8_SCHED; PG8_LDA(At, 1, 0); PG8_STAGE(PG8_SA(0, 1), a2 + hstep, voffA);
            PG8_WAIT_V(8); PG8_WAIT_L(0); PG8_BAR; PG8_MMA(0, 0, At, B0); PG8_MMA(0, 1, At, B1); PG8_BAR; PG8_SCHED;
            PG8_LDA(At, 1, 1); PG8_STAGE(PG8_SB(1, 0), b3, voffB); PG8_STAGE(PG8_SB(1, 1), b3 + hstep, voffB); PG8_STAGE(PG8_SA(1, 0), a3, voffA);
            PG8_WAIT_V(8); PG8_WAIT_L(0); PG8_BAR; PG8_MMA(1, 0, At, B0); PG8_MMA(1, 1, At, B1); PG8_BAR; PG8_SCHED;
            } else {
            PG8_LDB(B0, 0, 0); PG8_SCHED; PG8_LDA(At, 0, 0); PG8_STAGE(PG8_SA(1, 1), a1 + hstep, voffA);
            PG8_WAIT_L(8); PG8_BAR; PG8_WAIT_L(0); PG8_MMA(0, 0, At, B0); PG8_BAR; PG8_SCHED;
            PG8_LDB(B1, 0, 1); PG8_STAGE(PG8_SB(0, 0), b2, voffB);
            PG8_BAR; PG8_WAIT_L(0); PG8_MMA(0, 1, At, B1); PG8_BAR;
            PG8_LDA(At, 0, 1); PG8_STAGE(PG8_SA(0, 0), a2, voffA);
            PG8_BAR; PG8_WAIT_L(0); PG8_MMA(1, 0, At, B0); PG8_BAR; PG8_SCHED;
            PG8_STAGE(PG8_SB(0, 1), b2 + hstep, voffB);
            PG8_WAIT_V(6); PG8_BAR; PG8_MMA(1, 1, At, B1); PG8_BAR;
            PG8_LDB(B0, 1, 0); PG8_SCHED; PG8_LDA(At, 1, 0); PG8_STAGE(PG8_SA(0, 1), a2 + hstep, voffA);
            PG8_WAIT_L(8); PG8_BAR; PG8_WAIT_L(0); PG8_MMA(0, 0, At, B0); PG8_BAR; PG8_SCHED;
            PG8_LDB(B1, 1, 1); PG8_STAGE(PG8_SB(1, 0), b3, voffB);
            PG8_BAR; PG8_WAIT_L(0); PG8_MMA(0, 1, At, B1); PG8_BAR;
            PG8_LDA(At, 1, 1); PG8_STAGE(PG8_SA(1, 0), a3, voffA);
            PG8_BAR; PG8_WAIT_L(0); PG8_MMA(1, 0, At, B0); PG8_BAR; PG8_SCHED;
            PG8_STAGE(PG8_SB(1, 1), b3 + hstep, voffB);
            PG8_WAIT_V(6); PG8_BAR; PG8_MMA(1, 1, At, B1); PG8_BAR;
            }
        }
        if constexpr (ALIGN_EPI) { if (wr == 0) PG8_BAR; }
        if constexpr (!Epi::AFTER_DRAIN) { E(acc, cur, wr, wc, fr, fq); S.done(cur); }
        if (!has_next) break;
#pragma unroll
        for (int a = 0; a < 2; ++a)
#pragma unroll
            for (int b = 0; b < 2; ++b)
#pragma unroll
                for (int m = 0; m < 4; ++m)
#pragma unroll
                    for (int n = 0; n < 2; ++n) acc[a][b][m][n] = (f32x4){0.f, 0.f, 0.f, 0.f};
        cur = nxt; cA = nA; cB = nB; ++ui;
        if constexpr (ALIGN_EPI) { if (wr == 1) PG8_BAR; }
    }
    PG8_WAIT_V(0);
    if constexpr (!ALIGN_EPI) { if (wr == 0) PG8_BAR; }
    PG8_BAR;
    if constexpr (Epi::AFTER_DRAIN) { E.fused(acc, cur, wr, wc, fr, fq, lds, wid, lane); S.done(cur); }
#undef PG8_SA
#undef PG8_SB
#undef PG8_STAGE
#undef PG8_LDA
#undef PG8_LDB
#undef PG8_MMA
#undef PG8_WAIT_V
#undef PG8_WAIT_L
#undef PG8_BAR
#undef PG8_SCHED
}
}

typedef unsigned short bf16;
typedef unsigned v4u __attribute__((ext_vector_type(4)));
typedef float f32x4 __attribute__((ext_vector_type(4)));
#define GAS __attribute__((address_space(1)))
#define LDS_WAIT() asm volatile("s_waitcnt lgkmcnt(0)" ::: "memory")
#define VM_WAIT() asm volatile("s_waitcnt vmcnt(0)" ::: "memory")
__device__ __forceinline__ unsigned f2bf(float f) { unsigned u = __builtin_bit_cast(unsigned, f); return (u + 0x7fffu + ((u >> 16) & 1u)) >> 16; }
__device__ __forceinline__ unsigned pk2(float lo, float hi) { return f2bf(lo) | (f2bf(hi) << 16); }
__device__ __forceinline__ float bf2f(unsigned short v) { return __builtin_bit_cast(float, (unsigned)v << 16); }

struct Frame {
    LAS unsigned char* lds;
    int tid, vb, vt, nvb;
    int lane, wave, G, vcu;
    unsigned* ctl;
    float* modp; bf16* w_in_t; bf16* h1b; bf16* w_out_t; bf16* wr_t; bf16* ws_down_t; bf16* ycatb; bf16* h2b; bf16* sactb; float* rsg; bf16* actb; bf16* contribb;
    const float *x, *c, *w_ada, *b_ada, *w_in, *rel_bias, *attn_gain, *ret_gain, *w_out, *ln1_g, *ln1_b, *w_router, *router_bias, *w_gate, *w_up, *w_down, *ws_gate, *ws_up, *ws_down, *ln2_g, *ln2_b;
    float* out;
    int* counts; float* mod; float* cs; float* h1; float* proj; float* qr; float* kr; float* attn_out; float* U; float* R; float* ycat; float* mixer; float* x1; float* h2;
    float* logits; int* lists; int* a_exp; float* a_w; float* act; float* contrib; float* sgu; float* sact; float* sh_out;
};
#define VB_FOR(u, N) for (int _b = (int)blockIdx.x * 2, u = _b + F.vb; _b < (N); _b += (int)gridDim.x * 2, u = _b + F.vb)

__device__ __forceinline__ void ph_gemm(Frame& F, const float* __restrict__ A, int lda, const float* __restrict__ B, int ldb, float* __restrict__ C, int ldc, int M, int N, int K) {
    LAS float* As = (LAS float*)(F.lds + F.vb * 16384);
    LAS float* Bs = As + 16 * 68;
    const int tid = F.vt, tx = tid & 15, ty = tid >> 4, ntn = N / 64, ntiles = (M / 64) * ntn;
    VB_FOR(u, ntiles) {
        const int m0 = (u / ntn) * 64, n0 = (u % ntn) * 64;
        float acc[4][4];
#pragma unroll
        for (int i = 0; i < 4; ++i)
#pragma unroll
            for (int j = 0; j < 4; ++j) acc[i][j] = 0.f;
        for (int k0 = 0; k0 < K; k0 += 16) {
            {
                const int r = tid >> 2, c4 = (tid & 3) * 4;
                const float4 v = *(const float4*)(A + (size_t)(m0 + r) * lda + k0 + c4);
                As[(c4 + 0) * 68 + r] = v.x; As[(c4 + 1) * 68 + r] = v.y; As[(c4 + 2) * 68 + r] = v.z; As[(c4 + 3) * 68 + r] = v.w;
                const int kr = tid >> 4, cc = (tid & 15) * 4;
                const float4 w = *(const float4*)(B + (size_t)(k0 + kr) * ldb + n0 + cc);
                Bs[kr * 68 + cc + 0] = w.x; Bs[kr * 68 + cc + 1] = w.y; Bs[kr * 68 + cc + 2] = w.z; Bs[kr * 68 + cc + 3] = w.w;
            }
            __syncthreads();
#pragma unroll
            for (int kk = 0; kk < 16; ++kk) {
                float a[4], b[4];
#pragma unroll
                for (int i = 0; i < 4; ++i) a[i] = As[kk * 68 + ty * 4 + i];
#pragma unroll
                for (int j = 0; j < 4; ++j) b[j] = Bs[kk * 68 + tx * 4 + j];
#pragma unroll
                for (int i = 0; i < 4; ++i)
#pragma unroll
                    for (int j = 0; j < 4; ++j) acc[i][j] += a[i] * b[j];
            }
            __syncthreads();
        }
#pragma unroll
        for (int i = 0; i < 4; ++i)
#pragma unroll
            for (int j = 0; j < 4; ++j) C[(size_t)(m0 + ty * 4 + i) * ldc + n0 + tx * 4 + j] = acc[i][j];
    }
}

__device__ __forceinline__ void ph_mod_rope(Frame& F) {
    const int gt = (int)blockIdx.x * 512 + F.tid, GT = (int)gridDim.x * 512;
    for (int i = gt; i < 2 * 6 * D_MODEL; i += GT) {
        const int b = i / (6 * D_MODEL), n = i % (6 * D_MODEL);
        float acc = 0.f;
        for (int k = 0; k < D_MODEL; ++k) acc += silu_f(F.c[b * D_MODEL + k]) * F.w_ada[(size_t)k * (6 * D_MODEL) + n];
        F.mod[i] = acc + F.b_ada[n];
    }
    for (int i = gt; i < SEQ * 32; i += GT) {
        const int s = i >> 5, j = i & 31;
        const float inv = powf(10000.0f, -(float)j / 32.0f);
        const float ang = (float)s * inv;
        F.cs[2 * i] = cosf(ang); F.cs[2 * i + 1] = sinf(ang);
    }
}
__device__ __forceinline__ void ph_modulate(Frame& F) {
    const size_t gt = (size_t)blockIdx.x * 512 + F.tid, GT = (size_t)gridDim.x * 512;
    for (size_t i = gt; i < (size_t)NTOK * D_MODEL; i += GT) {
        const int t = (int)(i / D_MODEL), d = (int)(i % D_MODEL), b = t / SEQ;
        F.h1[i] = F.x[i] * (1.0f + F.mod[b * 6 * D_MODEL + D_MODEL + d]) + F.mod[b * 6 * D_MODEL + d];
    }
}
__device__ __forceinline__ void ph_band_attn(Frame& F) {
    const float* __restrict__ proj = F.proj;
    VB_FOR(u, 1024) {
        const int c = u & 63, h = (u >> 6) & 7, b = u >> 9;
        const int tid = F.vt, i = tid >> 2, part = tid & 3;
        const size_t tq = (size_t)b * SEQ + c * 64 + i;
        float q[32], o[32];
        const float scale = 0.08838834764831845f;
#pragma unroll
        for (int d = 0; d < 32; ++d) { q[d] = proj[tq * IN_WIDTH + h * 128 + part * 32 + d] * scale; o[d] = 0.f; }
        float m = -1e30f, l = 0.f;
        for (int j = 0; j < 576; ++j) {
            const int kpos = c * 64 - 512 + j;
            if (kpos < 0) continue;
            const size_t tk = (size_t)b * SEQ + kpos;
            const float* kp = proj + tk * IN_WIDTH + 1024 + h * 128 + part * 32;
            float s = 0.f;
#pragma unroll
            for (int d = 0; d < 32; ++d) s += q[d] * kp[d];
            s += __shfl_xor(s, 1); s += __shfl_xor(s, 2);
            int dist = 512 + i - j; dist = dist < -63 ? -63 : (dist > 256 ? 256 : dist);
            s += F.rel_bias[h * 320 + dist + 63];
            const float mn = fmaxf(m, s), a = __expf(m - mn), p = __expf(s - mn);
            l = l * a + p; m = mn;
            const float* vp = proj + tk * IN_WIDTH + 2048 + h * 128 + part * 32;
#pragma unroll
            for (int d = 0; d < 32; ++d) o[d] = o[d] * a + p * vp[d];
        }
        const float il = 1.0f / l;
#pragma unroll
        for (int d = 0; d < 32; ++d) F.attn_out[tq * 1024 + h * 128 + part * 32 + d] = o[d] * il;
    }
}
__device__ __forceinline__ void ph_rot(Frame& F) {
    const size_t gt = (size_t)blockIdx.x * 512 + F.tid, GT = (size_t)gridDim.x * 512;
    for (size_t i = gt; i < (size_t)NTOK * 256; i += GT) {
        const int j = (int)(i & 31), h = (int)((i >> 5) & 7); const size_t t = i >> 8; const int s = (int)(t % SEQ);
        const float co = F.cs[(s * 32 + j) * 2], si = F.cs[(s * 32 + j) * 2 + 1];
        const float* pq = F.proj + t * IN_WIDTH + 3072 + h * 64; const float* pk = F.proj + t * IN_WIDTH + 3584 + h * 64;
        const float q1 = pq[j], q2 = pq[j + 32], k1 = pk[j], k2 = pk[j + 32];
        F.qr[t * 512 + h * 64 + j] = q1 * co - q2 * si; F.qr[t * 512 + h * 64 + 32 + j] = q2 * co + q1 * si;
        F.kr[t * 512 + h * 64 + j] = (k1 * co - k2 * si) * 0.125f; F.kr[t * 512 + h * 64 + 32 + j] = (k2 * co + k1 * si) * 0.125f;
    }
}
__device__ __forceinline__ void ph_rms(Frame& F) {
    const int lane = F.tid & 63, gw = (int)blockIdx.x * 8 + (F.tid >> 6), GW = (int)gridDim.x * 8;
    for (int t = gw; t < NTOK; t += GW) {
        float v[16]; float ss = 0.f;
#pragma unroll
        for (int j = 0; j < 16; ++j) { v[j] = F.attn_out[(size_t)t * 1024 + lane + 64 * j]; ss += v[j] * v[j]; }
        for (int o = 32; o > 0; o >>= 1) ss += __shfl_xor(ss, o);
        const float rs = rsqrtf(ss / 1024.0f + EPS_F);
#pragma unroll
        for (int j = 0; j < 16; ++j) F.ycatb[(size_t)t * D_MODEL + lane + 64 * j] = (bf16)f2bf(v[j] * rs * F.attn_gain[lane + 64 * j]);
    }
}
__device__ __forceinline__ void ph_ret_u(Frame& F) {
    VB_FOR(u, 1024) {
        const int c = u & 63, h = (u >> 6) & 7, b = u >> 9, tid = F.vt, kk = tid >> 2, part = tid & 3;
        const float lg = log_gamma(h);
        float acc[32];
#pragma unroll
        for (int d = 0; d < 32; ++d) acc[d] = 0.f;
        for (int m = 0; m < 64; ++m) {
            const size_t t = (size_t)b * SEQ + c * 64 + m;
            const float kv = F.kr[t * 512 + h * 64 + kk] * __expf(lg * (float)(63 - m));
            const float* vp = F.proj + t * IN_WIDTH + 4096 + h * 128 + part * 32;
#pragma unroll
            for (int d = 0; d < 32; ++d) acc[d] += kv * vp[d];
        }
        float* up = F.U + ((((size_t)b * 8 + h) * 64 + c) * 64 + kk) * 128 + part * 32;
#pragma unroll
        for (int d = 0; d < 32; ++d) up[d] = acc[d];
    }
}
__device__ __forceinline__ void ph_ret_scan(Frame& F) {
    const int gt = (int)blockIdx.x * 512 + F.tid, GT = (int)gridDim.x * 512;
    for (int i = gt; i < 2 * 8 * 8192; i += GT) {
        const int e = i & 8191, bh = i >> 13, h = bh & 7;
        const float g = __expf(log_gamma(h) * 64.0f);
        float st = 0.f;
        for (int c = 0; c < 64; ++c) { const size_t o = ((size_t)bh * 64 + c) * 8192 + e; F.R[o] = st; st = g * st + F.U[o]; }
    }
}
__device__ __forceinline__ void ph_ret_out(Frame& F) {
    VB_FOR(u, 1024) {
        const int c = u & 63, h = (u >> 6) & 7, b = u >> 9, tid = F.vt, n = tid >> 2, part = tid & 3;
        const float lg = log_gamma(h);
        const size_t tn = (size_t)b * SEQ + c * 64 + n;
        float q[16], o[32];
#pragma unroll
        for (int d = 0; d < 16; ++d) q[d] = F.qr[tn * 512 + h * 64 + part * 16 + d];
#pragma unroll
        for (int d = 0; d < 32; ++d) o[d] = 0.f;
        for (int m = 0; m < 64; ++m) {
            const size_t tm = (size_t)b * SEQ + c * 64 + m;
            const float* kp = F.kr + tm * 512 + h * 64 + part * 16;
            float s = 0.f;
#pragma unroll
            for (int d = 0; d < 16; ++d) s += q[d] * kp[d];
            s += __shfl_xor(s, 1); s += __shfl_xor(s, 2);
            const int dd = n > m ? n - m : m - n;
            s *= __expf(lg * (float)dd);
            const float* vp = F.proj + tm * IN_WIDTH + 4096 + h * 128 + part * 32;
#pragma unroll
            for (int d = 0; d < 32; ++d) o[d] += s * vp[d];
        }
        const float xi = __expf(lg * (float)(n + 1));
        const float* Rp = F.R + (((size_t)b * 8 + h) * 64 + c) * 8192;
        for (int kk = 0; kk < 64; ++kk) {
            const float qv = F.qr[tn * 512 + h * 64 + kk] * xi;
            const float* rp = Rp + kk * 128 + part * 32;
#pragma unroll
            for (int d = 0; d < 32; ++d) o[d] += qv * rp[d];
        }
        float s1 = 0.f;
#pragma unroll
        for (int d = 0; d < 32; ++d) s1 += o[d];
        s1 += __shfl_xor(s1, 1); s1 += __shfl_xor(s1, 2);
        const float mu = s1 / 128.0f; float s2 = 0.f;
#pragma unroll
        for (int d = 0; d < 32; ++d) { const float dv = o[d] - mu; s2 += dv * dv; }
        s2 += __shfl_xor(s2, 1); s2 += __shfl_xor(s2, 2);
        const float rs = rsqrtf(s2 / 128.0f + EPS_F);
#pragma unroll
        for (int d = 0; d < 32; ++d) {
            const int col = h * 128 + part * 32 + d;
            const float gb = F.proj[tn * IN_WIDTH + 5120 + col];
            F.ycatb[tn * D_MODEL + 1024 + col] = (bf16)f2bf(silu_f(gb) * (o[d] - mu) * rs * F.ret_gain[col]);
        }
    }
}
__device__ __forceinline__ void ph_res_ln(Frame& F, const float* __restrict__ xres, const float* __restrict__ y, const bf16* __restrict__ contrib, int g_off,
                                          const float* __restrict__ gain, const float* __restrict__ bias, float* __restrict__ xo, int sh_off, int sc_off, float* __restrict__ hmod) {
    const int lane = F.tid & 63, gw = (int)blockIdx.x * 8 + (F.tid >> 6), GW = (int)gridDim.x * 8;
    for (int t = gw; t < NTOK; t += GW) {
        const int b = t / SEQ;
        float z[32]; float s = 0.f;
#pragma unroll
        for (int j = 0; j < 32; ++j) {
            const int d = lane + 64 * j; float yy = y[(size_t)t * D_MODEL + d];
            if (contrib) {
#pragma unroll
                for (int k = 0; k < 8; ++k) yy += bf2f(contrib[((size_t)t * 8 + k) * D_MODEL + d]);
            }
            z[j] = ALPHA_F * xres[(size_t)t * D_MODEL + d] + F.mod[b * 6 * D_MODEL + g_off + d] * yy; s += z[j];
        }
        for (int o = 32; o > 0; o >>= 1) s += __shfl_xor(s, o);
        const float mu = s / (float)D_MODEL; float q = 0.f;
#pragma unroll
        for (int j = 0; j < 32; ++j) { const float dv = z[j] - mu; q += dv * dv; }
        for (int o = 32; o > 0; o >>= 1) q += __shfl_xor(q, o);
        const float rs = rsqrtf(q / (float)D_MODEL + EPS_F);
#pragma unroll
        for (int j = 0; j < 32; ++j) {
            const int d = lane + 64 * j; const float v = (z[j] - mu) * rs * gain[d] + bias[d];
            xo[(size_t)t * D_MODEL + d] = v;
            if (hmod) { const float hv = v * (1.0f + F.mod[b * 6 * D_MODEL + sc_off + d]) + F.mod[b * 6 * D_MODEL + sh_off + d]; hmod[(size_t)t * D_MODEL + d] = hv; F.h2b[(size_t)t * D_MODEL + d] = (bf16)f2bf(hv); }
        }
    }
}
__device__ __forceinline__ void ph_route(Frame& F) {
    LAS float* sb = (LAS float*)(F.lds + F.vb * 4096); LAS float* ssc = sb + 256; LAS float* gs = ssc + 256; LAS int* gsel = (LAS int*)(gs + 8); LAS int* pick = gsel + 8;
    const int e = F.vt;
    VB_FOR(t, NTOK) {
        const float sc = sigmoid_f(F.rsg[(size_t)t * 768 + e]); const float bi = sc + F.router_bias[e];
        __syncthreads();
        ssc[e] = sc; sb[e] = bi;
        __syncthreads();
        if (e < 8) { float t1 = -1e30f, t2 = -1e30f; for (int i = 0; i < 32; ++i) { const float v = sb[e * 32 + i]; if (v > t1) { t2 = t1; t1 = v; } else if (v > t2) t2 = v; } gs[e] = t1 + t2; gsel[e] = 0; }
        __syncthreads();
        if (e == 0) {
            for (int r = 0; r < 4; ++r) { int bi_ = 0; float bv = -1e30f; for (int g = 0; g < 8; ++g) if (!gsel[g] && gs[g] > bv) { bv = gs[g]; bi_ = g; } gsel[bi_] = 1; }
        }
        __syncthreads();
        if (!gsel[e >> 5]) sb[e] = -1e30f;
        __syncthreads();
        if (e == 0) {
            float wsum = 0.f;
            for (int r = 0; r < 8; ++r) { int bi_ = 0; float bv = -2e30f; for (int i = 0; i < 256; ++i) if (sb[i] > bv) { bv = sb[i]; bi_ = i; } pick[r] = bi_; sb[bi_] = -3e30f; wsum += ssc[bi_]; }
            for (int r = 0; r < 8; ++r) {
                const int ex = pick[r]; const int slot = atomicAdd(&F.counts[ex], 1);
                F.lists[ex * NTOK + slot] = t * 8 + r; F.a_exp[t * 8 + r] = ex; F.a_w[t * 8 + r] = ssc[ex] / wsum * 2.5f;
            }
        }
    }
}
__device__ __forceinline__ void ph_swiglu_act(Frame& F) {
    const size_t gt = (size_t)blockIdx.x * 512 + F.tid, GT = (size_t)gridDim.x * 512;
    for (size_t i = gt; i < (size_t)NTOK * 256; i += GT) { const size_t t = i >> 8; const int j = (int)(i & 255); F.sactb[i] = (bf16)f2bf(silu_f(F.rsg[t * 768 + 256 + j]) * F.rsg[t * 768 + 512 + j]); }
}
__device__ __forceinline__ void ph_moe_gu(Frame& F) {
    LAS float* hs = (LAS float*)(F.lds + F.vb * 8192);
    const int j = F.vt;
    for (int e = blockIdx.x; e < NEXP; e += gridDim.x) {
        const int cnt = F.counts[e];
        const float* wgp = F.w_gate + (size_t)e * D_MODEL * EDIM; const float* wup = F.w_up + (size_t)e * D_MODEL * EDIM;
        for (int t0 = 0; t0 < cnt; t0 += 16) {
            const int tile0 = t0 + F.vb * 8;
            int aid[8];
#pragma unroll
            for (int i = 0; i < 8; ++i) { const int s = tile0 + i; aid[i] = s < cnt ? F.lists[e * NTOK + s] : -1; }
            float ag[8], au[8];
#pragma unroll
            for (int i = 0; i < 8; ++i) { ag[i] = 0.f; au[i] = 0.f; }
            for (int k0 = 0; k0 < D_MODEL; k0 += 256) {
                __syncthreads();
#pragma unroll
                for (int i = 0; i < 8; ++i) hs[i * 256 + j] = aid[i] >= 0 ? F.h2[(size_t)(aid[i] >> 3) * D_MODEL + k0 + j] : 0.f;
                __syncthreads();
                for (int kk = 0; kk < 256; ++kk) {
                    const float a = wgp[(size_t)(k0 + kk) * EDIM + j], u = wup[(size_t)(k0 + kk) * EDIM + j];
#pragma unroll
                    for (int i = 0; i < 8; ++i) { const float hv = hs[i * 256 + kk]; ag[i] += hv * a; au[i] += hv * u; }
                }
            }
#pragma unroll
            for (int i = 0; i < 8; ++i) if (aid[i] >= 0) F.act[(size_t)aid[i] * EDIM + j] = silu_f(ag[i]) * au[i];
        }
    }
}
__device__ __forceinline__ void ph_moe_down(Frame& F) {
    LAS float* as = (LAS float*)(F.lds + F.vb * 8192);
    const int j = F.vt;
    for (int e = blockIdx.x; e < NEXP; e += gridDim.x) {
        const int cnt = F.counts[e];
        for (int t0 = 0; t0 < cnt; t0 += 16) {
            const int tile0 = t0 + F.vb * 8;
            int aid[8];
#pragma unroll
            for (int i = 0; i < 8; ++i) { const int s = tile0 + i; aid[i] = s < cnt ? F.lists[e * NTOK + s] : -1; }
            __syncthreads();
#pragma unroll
            for (int i = 0; i < 8; ++i) as[i * 256 + j] = aid[i] >= 0 ? F.act[(size_t)aid[i] * EDIM + j] : 0.f;
            __syncthreads();
            for (int half = 0; half < 2; ++half) {
                float acc[4][8];
#pragma unroll
                for (int c = 0; c < 4; ++c)
#pragma unroll
                    for (int i = 0; i < 8; ++i) acc[c][i] = 0.f;
                const float* wp = F.w_down + (size_t)e * EDIM * D_MODEL + half * 1024 + j;
                for (int kk = 0; kk < 256; ++kk) {
                    float w[4];
#pragma unroll
                    for (int c = 0; c < 4; ++c) w[c] = wp[(size_t)kk * D_MODEL + 256 * c];
#pragma unroll
                    for (int i = 0; i < 8; ++i) { const float a = as[i * 256 + kk];
#pragma unroll
                        for (int c = 0; c < 4; ++c) acc[c][i] += a * w[c]; }
                }
#pragma unroll
                for (int i = 0; i < 8; ++i) if (aid[i] >= 0) { const float rw = F.a_w[aid[i]];
#pragma unroll
                    for (int c = 0; c < 4; ++c) F.contrib[(size_t)aid[i] * D_MODEL + half * 1024 + j + 256 * c] = rw * acc[c][i]; }
            }
        }
    }
}


__device__ __forceinline__ float wave_sum(float v) {
#pragma unroll
    for (int o = 1; o < 64; o <<= 1) v += __shfl_xor(v, o);
    return v;
}
__device__ __forceinline__ void p0_transpose_item(const float* W, int K, int N, bf16* WT, int row_off, LAS float* scr, int item, int lane) {
    const int nblk = N / 32, kb = item / nblk, nb = item % nblk, k0 = 64 * kb, n0 = 32 * nb;
#pragma unroll 8
    for (int i = 0; i < 32; ++i) { const int kk = 2 * i + (lane >> 5); scr[kk * 33 + (lane & 31)] = W[(size_t)(k0 + kk) * N + n0 + (lane & 31)]; }
    LDS_WAIT(); asm volatile("" ::: "memory");
    const int c = lane & 7;
#pragma unroll
    for (int j = 0; j < 4; ++j) { const int n = (lane >> 3) + 8 * j; const LAS float* s = scr + (8 * c) * 33 + n;
        v4u o; o.x = pk2(s[0 * 33], s[1 * 33]); o.y = pk2(s[2 * 33], s[3 * 33]); o.z = pk2(s[4 * 33], s[5 * 33]); o.w = pk2(s[6 * 33], s[7 * 33]);
        *(GAS v4u*)(WT + (size_t)(row_off + n0 + n) * K + k0 + 8 * c) = o; }
    LDS_WAIT(); asm volatile("" ::: "memory");
}
constexpr int CW_MODCNT = 12288;
__device__ __forceinline__ void p0_mod(Frame& F) {
    LAS float* red = (LAS float*)F.lds;
    volatile LAS unsigned* flag = (volatile LAS unsigned*)(F.lds + 65536);
    for (int p = blockIdx.x; p < 256; p += gridDim.x) {
        const int kr = p >> 4, cb = p & 15;
        f32x4 acc[2][3];
#pragma unroll
        for (int b = 0; b < 2; ++b)
#pragma unroll
            for (int j = 0; j < 3; ++j) acc[b][j] = (f32x4){0.f, 0.f, 0.f, 0.f};
        const int kbase = kr * 128 + F.wave * 16;
#pragma unroll 4
        for (int i = 0; i < 16; ++i) {
            const int k = kbase + i;
            const float s0 = silu_f(F.c[k]), s1 = silu_f(F.c[D_MODEL + k]);
            const float* wp = F.w_ada + (size_t)k * (6 * D_MODEL) + cb * 768 + F.lane * 4;
#pragma unroll
            for (int j = 0; j < 3; ++j) { const f32x4 w = *(const f32x4*)(wp + j * 256); acc[0][j] += w * s0; acc[1][j] += w * s1; }
        }
        __syncthreads();
#pragma unroll
        for (int b = 0; b < 2; ++b)
#pragma unroll
            for (int j = 0; j < 3; ++j) *(LAS f32x4*)(red + (F.wave * 2 + b) * 768 + j * 256 + F.lane * 4) = acc[b][j];
        __syncthreads();
        for (int o = F.tid; o < 1536; o += 512) {
            const int b = o / 768, n = o % 768; float s = 0.f;
#pragma unroll
            for (int w = 0; w < 8; ++w) s += red[(w * 2 + b) * 768 + n];
            F.modp[((size_t)kr * 2 + b) * (6 * D_MODEL) + cb * 768 + n] = s;
        }
        asm volatile("s_waitcnt vmcnt(0)" ::: "memory");
        __syncthreads();
        if (F.tid == 0) {
            __builtin_amdgcn_fence(__ATOMIC_RELEASE, "agent");
            asm volatile("s_waitcnt vmcnt(0)" ::: "memory");
            const unsigned old = __hip_atomic_fetch_add(F.ctl + CW_MODCNT + 64 * cb, 1u, __ATOMIC_RELAXED, __HIP_MEMORY_SCOPE_AGENT);
            const unsigned last = (old == 15u) ? 1u : 0u;
            if (last) { __builtin_amdgcn_fence(__ATOMIC_ACQUIRE, "agent"); asm volatile("s_waitcnt vmcnt(0)" ::: "memory"); }
            flag[0] = last;
        }
        __syncthreads();
        if (flag[0]) {
            for (int o = F.tid; o < 1536; o += 512) {
                const int b = o / 768, n = cb * 768 + o % 768; float s = F.b_ada[n];
#pragma unroll
                for (int r = 0; r < 16; ++r) s += F.modp[((size_t)r * 2 + b) * (6 * D_MODEL) + n];
                F.mod[b * 6 * D_MODEL + n] = s;
            }
        }
        __syncthreads();
    }
}
__device__ __forceinline__ void p0_prologue(Frame& F) {
    p0_mod(F);
    { const int gt = (int)blockIdx.x * 512 + F.tid, GT = (int)gridDim.x * 512;
      for (int i = gt; i < SEQ * 32; i += GT) { const int s = i >> 5, j = i & 31; const float inv = powf(10000.0f, -(float)j / 32.0f); const float ang = (float)s * inv; F.cs[2 * i] = cosf(ang); F.cs[2 * i + 1] = sinf(ang); } }
    __syncthreads();
    LAS float* scr = (LAS float*)(F.lds + F.wave * 16384);
    const int gw = F.vcu * 8 + F.wave, NGW = F.G * 8;
    constexpr int I_IN = (D_MODEL / 64) * (IN_WIDTH / 32);
    constexpr int I_OUT = (D_MODEL / 64) * (D_MODEL / 32), I_R = (D_MODEL / 64) * (256 / 32), I_D = (256 / 64) * (D_MODEL / 32);
    constexpr int NITEMS = I_IN + I_OUT + 3 * I_R + I_D;
    for (int it = gw; it < NITEMS; it += NGW) {
        int r = it;
        if (r < I_IN) { p0_transpose_item(F.w_in, D_MODEL, IN_WIDTH, F.w_in_t, 0, scr, r, F.lane); continue; } r -= I_IN;
        if (r < I_OUT) { p0_transpose_item(F.w_out, D_MODEL, D_MODEL, F.w_out_t, 0, scr, r, F.lane); continue; } r -= I_OUT;
        if (r < I_R) { p0_transpose_item(F.w_router, D_MODEL, 256, F.wr_t, 0, scr, r, F.lane); continue; } r -= I_R;
        if (r < I_R) { p0_transpose_item(F.ws_gate, D_MODEL, 256, F.wr_t, 256, scr, r, F.lane); continue; } r -= I_R;
        if (r < I_R) { p0_transpose_item(F.ws_up, D_MODEL, 256, F.wr_t, 512, scr, r, F.lane); continue; } r -= I_R;
        p0_transpose_item(F.ws_down, 256, D_MODEL, F.ws_down_t, 0, scr, r, F.lane);
    }
}
__device__ __forceinline__ void p1_modulate_bf16(Frame& F) {
    const size_t gt = (size_t)blockIdx.x * 512 + F.tid, GT = (size_t)gridDim.x * 512;
    for (size_t i = gt; i < (size_t)NTOK * D_MODEL / 8; i += GT) {
        const size_t e = i * 8; const int t = (int)(e / D_MODEL), d = (int)(e % D_MODEL), b = t / SEQ;
        const f32x4 x0 = *(const f32x4*)(F.x + e), x1 = *(const f32x4*)(F.x + e + 4);
        const float* mb = F.mod + b * 6 * D_MODEL;
        const f32x4 sh0 = *(const f32x4*)(mb + d), sh1 = *(const f32x4*)(mb + d + 4), sc0 = *(const f32x4*)(mb + D_MODEL + d), sc1 = *(const f32x4*)(mb + D_MODEL + d + 4);
        const f32x4 h0 = x0 * (sc0 + 1.0f) + sh0, h1 = x1 * (sc1 + 1.0f) + sh1;
        v4u o; o.x = pk2(h0[0], h0[1]); o.y = pk2(h0[2], h0[3]); o.z = pk2(h1[0], h1[1]); o.w = pk2(h1[2], h1[3]);
        *(v4u*)(F.h1b + e) = o;
    }
}

typedef float f32x16 __attribute__((ext_vector_type(16)));
typedef short bf16x8 __attribute__((ext_vector_type(8)));
constexpr int MOE_MC = 384, MOE_ABUF = MOE_MC * 128, MOE_BBUF = 128 * 128;
constexpr int MOE_TAB = 131072 + 1024;
#define MOE_WAITV(n) asm volatile("s_waitcnt vmcnt(" #n ")" ::: "memory")

__device__ __forceinline__ void moe_tables(Frame& F) {
    LAS int* cnt = (LAS int*)(F.lds + MOE_TAB); LAS int* order = cnt + 256; LAS int* offs = order + 256;
    __syncthreads();
    if (F.tid < 256) cnt[F.tid] = F.counts[F.tid];
    __syncthreads();
    if (F.tid < 256) {
        const int me = cnt[F.tid]; int rank = 0, pre = 0;
        for (int j = 0; j < 256; ++j) { const int cj = cnt[j]; rank += (cj > me || (cj == me && j < F.tid)) ? 1 : 0; pre += (j < F.tid) ? cj : 0; }
        order[rank] = F.tid; offs[F.tid] = pre;
    }
    __syncthreads();
}

template <int MODE>
__device__ __forceinline__ void moe_job(Frame& F, const int e, const int slice, const int chunk_base, const int nrows, const int row_off) {
    constexpr int PER = MODE ? 4 : 32, T = MODE ? 16 : 32;
    const int l = F.lane, w = F.wave, half = w >> 2, cp = w & 1, rg = w >> 1, h = l >> 5;
    const int nrb = (nrows + 31) >> 5;
    const int my_n = (nrb > rg) ? ((nrb - rg + 3) >> 2) : 0;
    LAS unsigned char* lds = F.lds;
    unsigned aoff[6];
    const unsigned char* abase = MODE ? (const unsigned char*)F.actb : (const unsigned char*)F.h2b;
#pragma unroll
    for (int j = 0; j < 6; ++j) {
        const int r = (w * 6 + j) * 8 + (l >> 3); const int rr = r < nrows ? r : nrows - 1;
        unsigned rowbyte;
        if (MODE == 0) { const int tok = F.lists[e * NTOK + chunk_base + rr] >> 3; rowbyte = (unsigned)tok * (D_MODEL * 2); }
        else rowbyte = (unsigned)(row_off + chunk_base + rr) * (EDIM * 2);
        aoff[j] = rowbyte + (unsigned)(((l & 7) ^ (r & 7)) << 4);
    }
    const int hl = F.tid & 255, cq = hl & 31, kg = hl >> 5;
    const float* bptr; unsigned bld;
    int ncol0;
    if (MODE == 0) { const int seg = cq >> 4, within = (cq & 15) * 4; bptr = (seg ? F.w_up : F.w_gate) + (size_t)e * D_MODEL * EDIM + (size_t)(kg * 8) * EDIM + 64 * slice + within; bld = EDIM;
                     ncol0 = ((within >> 5) * 2 + seg) * 32 + (within & 31); }
    else { bptr = F.w_down + (size_t)e * EDIM * D_MODEL + (size_t)(kg * 8) * D_MODEL + 512 * slice + cq * 4; bld = D_MODEL; ncol0 = cq * 4; }
    f32x4 breg[8];
#define MOE_ISSUE_B(tau) do { const int _sp = (tau) / PER, _kt = (tau) % PER; const float* _p = bptr + (size_t)_kt * 64 * bld + (MODE ? 128 * _sp : 0); \
        _Pragma("unroll") for (int _j = 0; _j < 8; ++_j) breg[_j] = *(const f32x4*)(_p + (size_t)_j * bld); } while (0)
#define MOE_ISSUE_A(tau) do { const unsigned _k = (unsigned)(((tau) % PER) * 128); LAS unsigned char* _d = lds + ((tau) & 1) * MOE_ABUF + w * 6144; \
        _Pragma("unroll") for (int _j = 0; _j < 6; ++_j) __builtin_amdgcn_global_load_lds((const unsigned*)(abase + aoff[_j] + _k), (LAS unsigned*)(_d + _j * 1024), 16, 0, 0); } while (0)
    f32x16 acc[3][2];
#pragma unroll
    for (int i = 0; i < 3; ++i)
#pragma unroll
        for (int c = 0; c < 2; ++c)
#pragma unroll
            for (int q = 0; q < 16; ++q) acc[i][c][q] = 0.f;
    const int fsw = l & 7;
    const unsigned boff = (unsigned)(2 * MOE_ABUF + (cp * 64 + (l & 31)) * 128), toff = (unsigned)((rg * 32 + (l & 31)) * 128);
    __syncthreads();
    MOE_ISSUE_A(0);
    asm volatile("" ::: "memory");
    if (half == 0) MOE_ISSUE_B(0);
    if (half == 1) MOE_ISSUE_B(1);
    asm volatile("" ::: "memory");
    for (int tau = 0; tau < T; ++tau) {
        const bool loader = (half == (tau & 1));
        if (loader) {
            LAS unsigned char* bb = lds + 2 * MOE_ABUF + (tau & 1) * MOE_BBUF;
#pragma unroll
            for (int i = 0; i < 4; ++i) {
                const int n = ncol0 + i;
                v4u o; o.x = pg8::cvt_pk_bf16(breg[0][i], breg[1][i]); o.y = pg8::cvt_pk_bf16(breg[2][i], breg[3][i]); o.z = pg8::cvt_pk_bf16(breg[4][i], breg[5][i]); o.w = pg8::cvt_pk_bf16(breg[6][i], breg[7][i]);
                *(LAS v4u*)(bb + n * 128 + ((kg ^ (n & 7)) << 4)) = o;
            }
            MOE_WAITV(0);
        } else {
            if (tau + 1 < T) MOE_WAITV(8); else MOE_WAITV(0);
        }
        asm volatile("s_waitcnt lgkmcnt(0)" ::: "memory");
        __builtin_amdgcn_s_barrier();
        asm volatile("" ::: "memory");
        if (tau + 1 < T) MOE_ISSUE_A(tau + 1);
        asm volatile("" ::: "memory");
        if (loader && tau + 2 < T) MOE_ISSUE_B(tau + 2);
        asm volatile("" ::: "memory");
        {
            const LAS unsigned char* ab = lds + (tau & 1) * MOE_ABUF + toff;
            const LAS unsigned char* bb = lds + (tau & 1) * MOE_BBUF + boff;
#pragma unroll
            for (int s = 0; s < 4; ++s) {
                const int co = ((2 * s + h) ^ fsw) << 4;
                const bf16x8 w0 = *(const LAS bf16x8*)(bb + co), w1 = *(const LAS bf16x8*)(bb + 32 * 128 + co);
#pragma unroll
                for (int i = 0; i < 3; ++i) if (i < my_n) {
                    const bf16x8 tf = *(const LAS bf16x8*)(ab + i * (4 * 32 * 128) + co);
                    acc[i][0] = __builtin_amdgcn_mfma_f32_32x32x16_bf16(w0, tf, acc[i][0], 0, 0, 0);
                    acc[i][1] = __builtin_amdgcn_mfma_f32_32x32x16_bf16(w1, tf, acc[i][1], 0, 0, 0);
                }
            }
        }
        if ((tau % PER) == PER - 1) {
            const int sp = tau / PER;
#pragma unroll
            for (int i = 0; i < 3; ++i) if (i < my_n) {
                const int R = (rg + 4 * i) * 32 + (l & 31); const bool valid = R < nrows;
                if (MODE == 0) {
                    bf16* dst = F.actb + (size_t)(row_off + chunk_base + R) * EDIM + 64 * slice + 32 * cp + 4 * h;
#pragma unroll
                    for (int g = 0; g < 4; ++g) {
                        float v[4];
#pragma unroll
                        for (int j = 0; j < 4; ++j) v[j] = silu_f(acc[i][0][4 * g + j]) * acc[i][1][4 * g + j];
                        uint2 o; o.x = pg8::cvt_pk_bf16(v[0], v[1]); o.y = pg8::cvt_pk_bf16(v[2], v[3]);
                        if (valid) *(uint2*)(dst + 8 * g) = o;
                    }
                } else {
                    const int aid = F.lists[e * NTOK + chunk_base + (valid ? R : 0)]; const float wt = F.a_w[aid];
                    bf16* dst = F.contribb + (size_t)aid * D_MODEL + 512 * slice + 128 * sp + cp * 64 + 4 * h;
#pragma unroll
                    for (int c = 0; c < 2; ++c)
#pragma unroll
                        for (int g = 0; g < 4; ++g) {
                            uint2 o; o.x = pg8::cvt_pk_bf16(acc[i][c][4 * g] * wt, acc[i][c][4 * g + 1] * wt); o.y = pg8::cvt_pk_bf16(acc[i][c][4 * g + 2] * wt, acc[i][c][4 * g + 3] * wt);
                            if (valid) *(uint2*)(dst + 32 * c + 8 * g) = o;
                        }
                }
            }
#pragma unroll
            for (int i = 0; i < 3; ++i)
#pragma unroll
                for (int c = 0; c < 2; ++c)
#pragma unroll
                    for (int q = 0; q < 16; ++q) acc[i][c][q] = 0.f;
        }
    }
    MOE_WAITV(0);
#undef MOE_ISSUE_A
#undef MOE_ISSUE_B
}
template <int MODE>
__device__ __forceinline__ void moe_stage(Frame& F) {
    moe_tables(F);
    const LAS int* cnt = (const LAS int*)(F.lds + MOE_TAB); const LAS int* order = cnt + 256; const LAS int* offs = order + 256;
    for (int j = blockIdx.x; j < 1024; j += gridDim.x) {
        const int e = order[j >> 2], slice = j & 3, n = cnt[e], ro = offs[e];
        for (int cb = 0; cb < n; cb += MOE_MC) moe_job<MODE>(F, e, slice, cb, (n - cb) < MOE_MC ? (n - cb) : MOE_MC, ro);
    }
    __syncthreads();
}

struct Args { const float* in[21]; float* out; unsigned char* ws; int ph_lo, ph_hi, li, pad; };
constexpr size_t WS_CTL_BYTES = 65536;

__global__ void __launch_bounds__(512, 2) mk_fwd(Args a) {
    extern __shared__ __attribute__((aligned(16))) unsigned char lds_raw[];
    Frame F;
    F.lds = (LAS unsigned char*)lds_raw;
    F.tid = threadIdx.x; F.vb = F.tid >> 8; F.vt = F.tid & 255; F.nvb = gridDim.x * 2;
    F.lane = F.tid & 63; F.wave = __builtin_amdgcn_readfirstlane(F.tid >> 6); F.G = gridDim.x;
    { const int bx = blockIdx.x; F.vcu = (F.G % 8 == 0) ? (bx % 8) * (F.G / 8) + bx / 8 : bx; }
    F.ctl = (unsigned*)a.ws;
    F.x = a.in[0]; F.c = a.in[1]; F.w_ada = a.in[2]; F.b_ada = a.in[3]; F.w_in = a.in[4]; F.rel_bias = a.in[5]; F.attn_gain = a.in[6]; F.ret_gain = a.in[7]; F.w_out = a.in[8];
    F.ln1_g = a.in[9]; F.ln1_b = a.in[10]; F.w_router = a.in[11]; F.router_bias = a.in[12]; F.w_gate = a.in[13]; F.w_up = a.in[14]; F.w_down = a.in[15]; F.ws_gate = a.in[16];
    F.ws_up = a.in[17]; F.ws_down = a.in[18]; F.ln2_g = a.in[19]; F.ln2_b = a.in[20]; F.out = a.out;
    {
        unsigned char* w = a.ws; size_t off = WS_CTL_BYTES;
#define CARVE(T, name, bytes) name = (T*)(w + off); off += (((size_t)(bytes)) + 255) & ~(size_t)255
        F.counts = (int*)(w + 61440);
        CARVE(float, F.mod, 2 * 6 * D_MODEL * 4); CARVE(float, F.cs, SEQ * 32 * 2 * 4); CARVE(float, F.h1, (size_t)NTOK * D_MODEL * 4); CARVE(float, F.proj, (size_t)NTOK * IN_WIDTH * 4);
        CARVE(float, F.qr, (size_t)NTOK * 512 * 4); CARVE(float, F.kr, (size_t)NTOK * 512 * 4); CARVE(float, F.attn_out, (size_t)NTOK * 1024 * 4);
        CARVE(float, F.U, (size_t)2 * 8 * 64 * 8192 * 4); CARVE(float, F.R, (size_t)2 * 8 * 64 * 8192 * 4); CARVE(float, F.ycat, (size_t)NTOK * D_MODEL * 4);
        CARVE(float, F.mixer, (size_t)NTOK * D_MODEL * 4); CARVE(float, F.x1, (size_t)NTOK * D_MODEL * 4); CARVE(float, F.h2, (size_t)NTOK * D_MODEL * 4);
        CARVE(float, F.logits, (size_t)NTOK * NEXP * 4); CARVE(int, F.lists, (size_t)NEXP * NTOK * 4); CARVE(int, F.a_exp, (size_t)NTOK * 8 * 4); CARVE(float, F.a_w, (size_t)NTOK * 8 * 4);
        CARVE(float, F.act, (size_t)NTOK * 8 * EDIM * 4); CARVE(float, F.contrib, (size_t)NTOK * 8 * D_MODEL * 4); CARVE(float, F.sgu, (size_t)NTOK * 512 * 4);
        CARVE(float, F.sact, (size_t)NTOK * 256 * 4); CARVE(float, F.sh_out, (size_t)NTOK * D_MODEL * 4);
        CARVE(float, F.modp, (size_t)16 * 2 * 6 * D_MODEL * 4); CARVE(bf16, F.w_in_t, (size_t)IN_WIDTH * D_MODEL * 2); CARVE(bf16, F.h1b, (size_t)NTOK * D_MODEL * 2);
        CARVE(bf16, F.w_out_t, (size_t)D_MODEL * D_MODEL * 2); CARVE(bf16, F.wr_t, (size_t)768 * D_MODEL * 2); CARVE(bf16, F.ws_down_t, (size_t)D_MODEL * 256 * 2);
        CARVE(bf16, F.ycatb, (size_t)NTOK * D_MODEL * 2); CARVE(bf16, F.h2b, (size_t)NTOK * D_MODEL * 2); CARVE(bf16, F.sactb, (size_t)NTOK * 256 * 2); CARVE(float, F.rsg, (size_t)NTOK * 768 * 4);
        CARVE(bf16, F.actb, (size_t)(NTOK * 8 + 512) * EDIM * 2); CARVE(bf16, F.contribb, (size_t)NTOK * 8 * D_MODEL * 2);
#undef CARVE
    }
    for (int u = F.tid; u < (LDS_BYTES - 131072) / 4; u += 512) ((LAS unsigned*)(F.lds + 131072))[u] = 0u;
    __syncthreads();
    volatile LAS unsigned* MISC = (volatile LAS unsigned*)(F.lds + MISC_OFF);
    XcdBarrier bar = xcd_barrier_post((unsigned*)a.ws + a.li * 4096, MISC + 8);
    const int lo = a.ph_lo, hi = a.ph_hi;
#define IN(k) (lo <= (k) && (k) < hi)
#define SEAM(k) do { if (IN(k) && IN((k) + 1)) xcd_barrier(bar); } while (0)
    if (IN(0)) { p0_prologue(F); } SEAM(0);
    if (IN(1)) { p1_modulate_bf16(F); } SEAM(1);
    if (IN(2)) {
        pg8::Gemm g{F.h1b, F.w_in_t, NTOK, IN_WIDTH, D_MODEL}; pg8::StaticOrder S; S.init(NTOK, IN_WIDTH, F.G, (int)blockIdx.x);
        pg8::EpiF32 E{F.proj, IN_WIDTH, 0};
        pg8::gemm_phase<pg8::EpiF32, pg8::StaticOrder, true, true>(F.lds, g, S, E);
    } SEAM(2);
    if (IN(3)) { ph_band_attn(F); ph_rot(F); } SEAM(3);
    if (IN(4)) { ph_rms(F); ph_ret_u(F); } SEAM(4);
    if (IN(5)) { ph_ret_scan(F); } SEAM(5);
    if (IN(6)) { ph_ret_out(F); } SEAM(6);
    if (IN(7)) {
        pg8::Gemm g{F.ycatb, F.w_out_t, NTOK, D_MODEL, D_MODEL}; pg8::StaticOrder S; S.init(NTOK, D_MODEL, F.G, (int)blockIdx.x);
        pg8::EpiF32 E{F.mixer, D_MODEL, 0};
        pg8::gemm_phase<pg8::EpiF32, pg8::StaticOrder, true, true>(F.lds, g, S, E);
    } SEAM(7);
    if (IN(8)) { ph_res_ln(F, F.x, F.mixer, nullptr, 2 * D_MODEL, F.ln1_g, F.ln1_b, F.x1, 3 * D_MODEL, 4 * D_MODEL, F.h2); } SEAM(8);
    if (IN(9)) {
        pg8::Gemm g{F.h2b, F.wr_t, NTOK, 768, D_MODEL}; pg8::StaticOrder S; S.init(NTOK, 768, F.G, (int)blockIdx.x);
        pg8::EpiF32 E{F.rsg, 768, 0};
        pg8::gemm_phase<pg8::EpiF32, pg8::StaticOrder, true, true>(F.lds, g, S, E);
    } SEAM(9);
    if (IN(10)) { ph_route(F); ph_swiglu_act(F); } SEAM(10);
    if (IN(11)) { moe_stage<0>(F);
        pg8::Gemm g{F.sactb, F.ws_down_t, NTOK, D_MODEL, 256}; pg8::StaticOrder S; S.init(NTOK, D_MODEL, F.G, (int)blockIdx.x);
        pg8::EpiF32 E{F.sh_out, D_MODEL, 0};
        pg8::gemm_phase<pg8::EpiF32, pg8::StaticOrder, true, true>(F.lds, g, S, E);
    } SEAM(11);
    if (IN(12)) { moe_stage<1>(F); } SEAM(12);
    if (IN(13)) { ph_res_ln(F, F.x1, F.sh_out, F.contribb, 5 * D_MODEL, F.ln2_g, F.ln2_b, F.out, 0, 0, nullptr); }
#undef IN
#undef SEAM
}

extern "C" void kernel_launch(void* const* d_in, const int* in_sizes, int n_in, void* d_out, int out_size, void* d_ws, size_t ws_size, hipStream_t stream) {
    static int grid = 0;
    if (grid == 0) {
        int dev = 0, cus = 0, per_cu = 0;
        if (hipGetDevice(&dev) != hipSuccess || hipDeviceGetAttribute(&cus, hipDeviceAttributeMultiprocessorCount, dev) != hipSuccess) { fprintf(stderr, "kernel_launch: device query failed\n"); grid = -1; return; }
        if (hipFuncSetAttribute((const void*)mk_fwd, hipFuncAttributeMaxDynamicSharedMemorySize, LDS_BYTES) != hipSuccess) { fprintf(stderr, "kernel_launch: hipFuncSetAttribute failed\n"); grid = -1; return; }
        if (hipOccupancyMaxActiveBlocksPerMultiprocessor(&per_cu, (const void*)mk_fwd, 512, LDS_BYTES) != hipSuccess || per_cu < 1)
            fprintf(stderr, "kernel_launch: occupancy query reports %d workgroups per CU\n", per_cu);
        (void)hipGetLastError();
        grid = cus;
    }
    if (grid < 0) return;
    if (hipMemsetAsync(d_ws, 0, WS_CTL_BYTES, stream) != hipSuccess) { fprintf(stderr, "kernel_launch: memset failed\n"); return; }
    Args a{};
    for (int i = 0; i < 21; ++i) a.in[i] = (const float*)d_in[i];
    a.out = (float*)d_out; a.ws = (unsigned char*)d_ws;
    for (int li = 0; li < MK_N_LAUNCHES; ++li) {
        a.ph_lo = li * N_PHASES / MK_N_LAUNCHES; a.ph_hi = (li + 1) * N_PHASES / MK_N_LAUNCHES; a.li = li;
        hipLaunchKernelGGL(mk_fwd, dim3(grid), dim3(512), LDS_BYTES, stream, a);
        const hipError_t le = hipPeekAtLastError();
        if (le != hipSuccess) { fprintf(stderr, "kernel_launch: launch %d failed: %s\n", li, hipGetErrorName(le)); break; }
    }
}
```

```cpp
#include <hip/hip_runtime.h>
#include <cstdint>
#include <cstdio>

#define D_MODEL 2048
#define SEQ 4096
#define NTOK 8192
#define IN_WIDTH 6144
#define NEXP 256
#define EDIM 256
#define ALPHA_F 1.189207115002721f
#define EPS_F 1e-5f
#define LAS __attribute__((address_space(3)))

#ifndef MK_N_LAUNCHES
#define MK_N_LAUNCHES 1
#endif
constexpr int N_PHASES = 14;
constexpr int LDS_BYTES = 147456;
constexpr int MISC_OFF = 131072 + 320;

__device__ __forceinline__ int lane_id() { int v; asm volatile("v_mbcnt_lo_u32_b32 %0, -1, 0\n\tv_mbcnt_hi_u32_b32 %0, -1, %0" : "=v"(v)); return v; }
#define XB_TMO      128
#define XB_XCNT(j)  (256  + 64 * (j))
#define XB_XSUB(j)  (1280 + 64 * (j))
#define XB_XGEN(j)  (2304 + 64 * (j))
#define XB_TOP      3328
#define XB_TOPGEN   3392
#define XCD_BAR_WORDS 3456
#define XB_SPIN_CAP (1u << 18)
__device__ __forceinline__ unsigned xb_ld(unsigned* p)              { return __hip_atomic_load(p, __ATOMIC_RELAXED, __HIP_MEMORY_SCOPE_AGENT); }
__device__ __forceinline__ unsigned xb_add(unsigned* p, unsigned v) { return __hip_atomic_fetch_add(p, v, __ATOMIC_RELAXED, __HIP_MEMORY_SCOPE_AGENT); }
__device__ __forceinline__ unsigned xb_xcc_id() { return (unsigned)__builtin_amdgcn_s_getreg((3 << 11) | 20) & 0xFu; }
#define XB_SPIN(cond, bar) do { unsigned _sp = 0; while (cond) { __builtin_amdgcn_s_sleep(1); \
    if ((++_sp & 255u) == 0u) { if (xb_ld(&(bar)[XB_TMO])) break; if (_sp > XB_SPIN_CAP) { atomicAdd(&(bar)[XB_TMO], 1u); break; } } } } while (0)
struct XcdBarrier { unsigned* bar; unsigned x; volatile LAS unsigned* st; int wave; };
__device__ __forceinline__ XcdBarrier xcd_barrier_post(unsigned* bar, volatile LAS unsigned* st, int wave) {
    XcdBarrier b; b.bar = bar; b.x = xb_xcc_id(); b.st = st; b.wave = wave;
    if (wave == 0 && lane_id() == 0) (void)xb_add(&bar[XB_XCNT(b.x)], 1u);
    return b;
}
__device__ __forceinline__ void xcd_barrier_complete(unsigned* bar, unsigned x, unsigned& nloc, unsigned& nx) {
    const unsigned G = gridDim.x * gridDim.y * gridDim.z;
    unsigned sum, cnt, mine, sp = 0u;
    for (;;) {
        sum = 0u; cnt = 0u; mine = 0u;
#pragma unroll
        for (unsigned j = 0; j < 16; ++j) { const unsigned c = xb_ld(&bar[XB_XCNT(j)]); sum += c; cnt += (c > 0u) ? 1u : 0u; mine = (j == x) ? c : mine; }
        if (sum == G) break;
        __builtin_amdgcn_s_sleep(1);
        if ((++sp & 255u) == 0u) { if (xb_ld(&bar[XB_TMO])) break; if (sp > XB_SPIN_CAP) { atomicAdd(&bar[XB_TMO], 1u); break; } }
    }
    nloc = mine > 0u ? mine : 1u; nx = cnt > 0u ? cnt : 1u;
}
__device__ __forceinline__ void xcd_barrier(const XcdBarrier& b) {
    asm volatile("s_waitcnt vmcnt(0)" ::: "memory");
    __syncthreads();
    if (b.wave == 0 && lane_id() == 0) {
        unsigned* bar = b.bar;
        __builtin_amdgcn_s_waitcnt(0);
        unsigned nloc = b.st[0], nx = b.st[1];
        if (nloc == 0u) { xcd_barrier_complete(bar, b.x, nloc, nx); b.st[0] = nloc; b.st[1] = nx; }
        const unsigned old = xb_add(&bar[XB_XSUB(b.x)], 1u);
        const unsigned gen = old / nloc;
        if (old + 1u == (gen + 1u) * nloc) {
            __builtin_amdgcn_fence(__ATOMIC_RELEASE, "agent");
            asm volatile("s_waitcnt vmcnt(0)" ::: "memory");
            const unsigned og = xb_add(&bar[XB_TOP], 1u);
            const unsigned tg = og / nx;
            if (og + 1u == (tg + 1u) * nx) xb_add(&bar[XB_TOPGEN], 1u);
            else XB_SPIN(xb_ld(&bar[XB_TOPGEN]) == tg, bar);
            __builtin_amdgcn_fence(__ATOMIC_ACQUIRE, "agent");
            xb_add(&bar[XB_XGEN(b.x)], 1u);
            asm volatile("s_waitcnt vmcnt(0)" ::: "memory");
        } else {
            XB_SPIN(xb_ld(&bar[XB_XGEN(b.x)]) == gen, bar);
            __builtin_amdgcn_fence(__ATOMIC_ACQUIRE, "agent");
            asm volatile("s_waitcnt vmcnt(0)" ::: "memory");
        }
    }
    __syncthreads();
}

__device__ __forceinline__ float silu_f(float v) { return v / (1.0f + __expf(-v)); }
__device__ __forceinline__ float sigmoid_f(float v) { return 1.0f / (1.0f + __expf(-v)); }
__device__ __forceinline__ float log_gamma(int h) { return logf(1.0f - exp2f(-5.0f - (float)h)); }

namespace pg8 {
#define PG8_LAS __attribute__((address_space(3)))
typedef unsigned short bf16_t;
typedef short bf16x8 __attribute__((ext_vector_type(8)));
typedef float f32x4 __attribute__((ext_vector_type(4)));
typedef unsigned u32x4 __attribute__((ext_vector_type(4)));
constexpr int BM = 256, BK = 64, HALF = 128, HTB = HALF * BK * 2  , STAGE_BYTES = 8 * HTB, NXCD = 8, WGM = 8;

__host__ __device__ __forceinline__ int lds_byte(int r, int c) { const int st = (r >> 4) * 2 + (c >> 5), rr = r & 15, cc = c & 31, ob = rr * 64 + cc * 2; return st * 1024 + (ob ^ (((ob >> 9) & 1) << 5)); }
__host__ __device__ __forceinline__ void stage_rc(int b, int& R, int& C) { const int st = b / 1024, sb = b % 1024, swz = sb ^ (((sb >> 9) & 1) << 5); R = (st >> 1) * 16 + swz / 64; C = (st & 1) * 32 + (swz % 64) / 2; }
__host__ __device__ __forceinline__ int perm32(int rho) { const int n = rho >> 4, i = rho & 15; return 8 * (i >> 2) + 4 * n + (i & 3); }

struct Unit { int pm, pn; };
struct Gemm { const bf16_t* A; const bf16_t* Bt; int M, N, K; };

struct StaticOrder {
    int nM, nN, nwg, G, c;
    __host__ __device__ void init(int M, int N, int G_, int c_) { nM = M / BM; nN = N / BM; nwg = nM * nN; G = G_; c = c_; }
    __host__ __device__ bool next(int i, Unit& u) const {
        const long L = (long)i * G + c; if (L >= nwg) return false;
        int wgid = (int)L; { const int q = nwg / NXCD, r = nwg % NXCD, xcd = wgid % NXCD, off = wgid / NXCD; wgid = (xcd < r ? xcd * (q + 1) : r * (q + 1) + (xcd - r) * q) + off; }
        const int nig = WGM * nN, gid = wgid / nig, fm = gid * WGM, gsz = (nM - fm) < WGM ? (nM - fm) : WGM;
        u.pm = fm + ((wgid % nig) % gsz); u.pn = (wgid % nig) / gsz; return true;
    }
    __device__ __forceinline__ void a_ready(const Unit&) const {}
    __device__ __forceinline__ void done(const Unit&) const {}
};

__device__ __forceinline__ unsigned cvt_pk_bf16(float lo, float hi) { unsigned r; asm volatile("v_cvt_pk_bf16_f32 %0, %1, %2" : "=v"(r) : "v"(lo), "v"(hi)); return r; }
struct EpiF32 {
    static constexpr bool PERM = true, AFTER_DRAIN = false, MIDK = false;
    float* C; int ldc; int midk_tile;
    __device__ __forceinline__ void midscale(f32x4 (&acc)[2][2][4][2], const Unit& u, int wr, int wc, int fr, int fq) const {}
    __device__ __forceinline__ void operator()(const f32x4 (&acc)[2][2][4][2], const Unit& u, int wr, int wc, int fr, int fq) const {
        const int row0 = u.pm * BM + wr * 64 + fr, col0 = u.pn * BM + wc * 32 + 8 * fq;
#pragma unroll
        for (int ai = 0; ai < 2; ++ai)
#pragma unroll
            for (int m = 0; m < 4; ++m) { float* rowp = C + (size_t)(row0 + ai * HALF + m * 16) * ldc + col0;
#pragma unroll
                for (int bj = 0; bj < 2; ++bj) { *(f32x4*)(rowp + bj * HALF) = acc[ai][bj][m][0]; *(f32x4*)(rowp + bj * HALF + 4) = acc[ai][bj][m][1]; } }
    }
};

struct EpiBf16P {
    static constexpr bool PERM = true, AFTER_DRAIN = false, MIDK = false;
    bf16_t* O; int ldc; int midk_tile;
    __device__ __forceinline__ void midscale(f32x4 (&acc)[2][2][4][2], const Unit& u, int wr, int wc, int fr, int fq) const {}
    __device__ __forceinline__ void operator()(const f32x4 (&acc)[2][2][4][2], const Unit& u, int wr, int wc, int fr, int fq) const {
        const int row0 = u.pm * BM + wr * 64 + fr, col0 = u.pn * BM + wc * 32 + 8 * fq;
#pragma unroll
        for (int ai = 0; ai < 2; ++ai)
#pragma unroll
            for (int m = 0; m < 4; ++m) { bf16_t* rowp = O + (size_t)(row0 + ai * HALF + m * 16) * ldc + col0;
#pragma unroll
                for (int bj = 0; bj < 2; ++bj) { const f32x4 v0 = acc[ai][bj][m][0], v1 = acc[ai][bj][m][1];
                    u32x4 w; w.x = cvt_pk_bf16(v0[0], v0[1]); w.y = cvt_pk_bf16(v0[2], v0[3]); w.z = cvt_pk_bf16(v1[0], v1[1]); w.w = cvt_pk_bf16(v1[2], v1[3]);
                    *(u32x4*)(rowp + bj * HALF) = w; } }
    }
};
struct EpiF32Mid {
    static constexpr bool PERM = true, AFTER_DRAIN = false, MIDK = true;
    float* C; int ldc; int midk_tile; const float* ssq;
    __device__ __forceinline__ void midscale(f32x4 (&acc)[2][2][4][2], const Unit& u, int wr, int wc, int fr, int fq) const {
#pragma unroll
        for (int ai = 0; ai < 2; ++ai)
#pragma unroll
            for (int m = 0; m < 4; ++m) {
                const int row = u.pm * BM + ai * HALF + wr * 64 + m * 16 + fr;
                const f32x4 a = *(const f32x4*)(ssq + (size_t)row * 8), b = *(const f32x4*)(ssq + (size_t)row * 8 + 4);
                const float tot = ((a[0] + a[1]) + (a[2] + a[3])) + ((b[0] + b[1]) + (b[2] + b[3]));
                const float rs = rsqrtf(tot * (1.0f / 1024.0f) + 1e-5f);
#pragma unroll
                for (int bj = 0; bj < 2; ++bj)
#pragma unroll
                    for (int n = 0; n < 2; ++n) acc[ai][bj][m][n] *= rs;
            }
    }
    __device__ __forceinline__ void operator()(const f32x4 (&acc)[2][2][4][2], const Unit& u, int wr, int wc, int fr, int fq) const {
        const int row0 = u.pm * BM + wr * 64 + fr, col0 = u.pn * BM + wc * 32 + 8 * fq;
#pragma unroll
        for (int ai = 0; ai < 2; ++ai)
#pragma unroll
            for (int m = 0; m < 4; ++m) { float* rowp = C + (size_t)(row0 + ai * HALF + m * 16) * ldc + col0;
#pragma unroll
                for (int bj = 0; bj < 2; ++bj) { *(f32x4*)(rowp + bj * HALF) = acc[ai][bj][m][0]; *(f32x4*)(rowp + bj * HALF + 4) = acc[ai][bj][m][1]; } }
    }
};
template <class Epi, class Sched, bool ALIGN_EPI = false, bool SP2 = false>
__device__ __forceinline__ void gemm_phase(PG8_LAS unsigned char* lds, const Gemm g, const Sched& S, const Epi& E, const int wid) {
    const int lane = lane_id(), tid = wid * 64 + lane, wr = wid >> 2, wc = wid & 3, fr = lane & 15, fq = lane >> 4;
    const int K = g.K, nt = K / BK;
    unsigned voffA[2], voffB[2];
#pragma unroll
    for (int i = 0; i < 2; ++i) { int R, C; stage_rc(tid * 16 + i * 8192, R, C); const int Rb = Epi::PERM ? ((R & ~31) + perm32(R & 31)) : R;
        voffA[i] = (unsigned)(R * K + C) * 2u; voffB[i] = (unsigned)(Rb * K + C) * 2u; }
    const size_t kstep = (size_t)(BK * 2);
    const size_t hstep = (size_t)HALF * K * 2;
    const size_t tstep = 2 * hstep;
    const unsigned ldsw = (unsigned)wid * 1024u;
    const int aoff = lds_byte(wr * 64 + fr, fq * 8), boff = lds_byte(wc * 32 + fr, fq * 8);
#define PG8_SA(b, h) (((b) * 2 + (h)) * HTB)
#define PG8_SB(b, h) ((4 + (b) * 2 + (h)) * HTB)
#define PG8_STAGE(bufoff, gbase, voff) do { _Pragma("unroll") for (int _i = 0; _i < 2; ++_i) \
        __builtin_amdgcn_global_load_lds((const unsigned*)((const char*)(gbase) + (voff)[_i]), (PG8_LAS unsigned*)(lds + (bufoff) + ldsw + _i * 8192), 16, 0, 0); } while (0)
#define PG8_LDA(dst, b, h) do { _Pragma("unroll") for (int m = 0; m < 4; ++m) _Pragma("unroll") for (int k = 0; k < 2; ++k) dst[m][k] = *(const PG8_LAS bf16x8*)(lds + PG8_SA(b, h) + aoff + m * 2048 + k * 1024); } while (0)
#define PG8_LDB(dst, b, h) do { _Pragma("unroll") for (int n = 0; n < 2; ++n) _Pragma("unroll") for (int k = 0; k < 2; ++k) dst[n][k] = *(const PG8_LAS bf16x8*)(lds + PG8_SB(b, h) + boff + n * 2048 + k * 1024); } while (0)
#define PG8_MMA(ai, bj, At, Bt) do { __builtin_amdgcn_s_setprio(1); _Pragma("unroll") for (int m = 0; m < 4; ++m) _Pragma("unroll") for (int n = 0; n < 2; ++n) _Pragma("unroll") for (int k = 0; k < 2; ++k) \
        acc[ai][bj][m][n] = __builtin_amdgcn_mfma_f32_16x16x32_bf16(Bt[n][k], At[m][k], acc[ai][bj][m][n], 0, 0, 0); __builtin_amdgcn_s_setprio(0); } while (0)
#define PG8_WAIT_V(n) asm volatile("s_waitcnt vmcnt(" #n ")" ::: "memory")
#define PG8_WAIT_L(n) asm volatile("s_waitcnt lgkmcnt(" #n ")" ::: "memory")
#define PG8_BAR __builtin_amdgcn_s_barrier()
#define PG8_SCHED __builtin_amdgcn_sched_barrier(0)
    Unit cur, nxt; int ui = 0;
    if (!S.next(0, cur)) return;
    f32x4 acc[2][2][4][2];
#pragma unroll
    for (int a = 0; a < 2; ++a)
#pragma unroll
        for (int b = 0; b < 2; ++b)
#pragma unroll
            for (int m = 0; m < 4; ++m)
#pragma unroll
                for (int n = 0; n < 2; ++n) acc[a][b][m][n] = (f32x4){0.f, 0.f, 0.f, 0.f};
    bf16x8 At[4][2], B0[2][2], B1[2][2];
    const char* cA = (const char*)g.A + (size_t)cur.pm * tstep; const char* cB = (const char*)g.Bt + (size_t)cur.pn * tstep;
    S.a_ready(cur);
    if constexpr (SP2) {
        PG8_STAGE(PG8_SB(0, 0), cB, voffB); PG8_STAGE(PG8_SB(0, 1), cB + hstep, voffB); PG8_STAGE(PG8_SA(0, 0), cA, voffA); PG8_STAGE(PG8_SA(0, 1), cA + hstep, voffA);
        if (wr == 1) PG8_BAR;
        PG8_WAIT_V(2); PG8_BAR;
        PG8_STAGE(PG8_SB(1, 0), cB + kstep, voffB); PG8_STAGE(PG8_SA(1, 0), cA + kstep, voffA); PG8_STAGE(PG8_SB(1, 1), cB + hstep + kstep, voffB);
        PG8_WAIT_V(6); PG8_BAR;
    } else {
        PG8_STAGE(PG8_SB(0, 0), cB, voffB); PG8_STAGE(PG8_SA(0, 0), cA, voffA); PG8_STAGE(PG8_SB(0, 1), cB + hstep, voffB); PG8_STAGE(PG8_SA(0, 1), cA + hstep, voffA);
        if (wr == 1) PG8_BAR;
        PG8_WAIT_V(4); PG8_BAR;
        PG8_STAGE(PG8_SB(1, 0), cB + kstep, voffB); PG8_STAGE(PG8_SA(1, 0), cA + kstep, voffA); PG8_STAGE(PG8_SB(1, 1), cB + hstep + kstep, voffB);
        PG8_WAIT_V(6); PG8_BAR;
    }
    for (;;) {
        const bool has_next = S.next(ui + 1, nxt);
        const char* nA = has_next ? (const char*)g.A + (size_t)nxt.pm * tstep : cA; const char* nB = has_next ? (const char*)g.Bt + (size_t)nxt.pn * tstep : cB;
        for (int t = 0; t < nt; t += 2) {
            const bool last = (t == nt - 2);
            if constexpr (Epi::MIDK) { if (t == E.midk_tile) E.midscale(acc, cur, wr, wc, fr, fq); }
            const char* a1 = cA + (size_t)(t + 1) * kstep;
            const char* a2 = last ? nA : cA + (size_t)(t + 2) * kstep; const char* b2 = last ? nB : cB + (size_t)(t + 2) * kstep;
            const char* a3 = a2 + kstep; const char* b3 = b2 + kstep;
            if (last && has_next) S.a_ready(nxt);
            if constexpr (SP2) {
            PG8_LDB(B0, 0, 0); PG8_LDB(B1, 0, 1); PG8_SCHED; PG8_LDA(At, 0, 0); PG8_STAGE(PG8_SA(1, 1), a1 + hstep, voffA);
            PG8_WAIT_V(8); PG8_WAIT_L(0); PG8_BAR; PG8_MMA(0, 0, At, B0); PG8_MMA(0, 1, At, B1); PG8_BAR; PG8_SCHED;
            PG8_LDA(At, 0, 1); PG8_STAGE(PG8_SB(0, 0), b2, voffB); PG8_STAGE(PG8_SB(0, 1), b2 + hstep, voffB); PG8_STAGE(PG8_SA(0, 0), a2, voffA);
            PG8_WAIT_V(8); PG8_WAIT_L(0); PG8_BAR; PG8_MMA(1, 0, At, B0); PG8_MMA(1, 1, At, B1); PG8_BAR; PG8_SCHED;
            PG8_LDB(B0, 1, 0); PG8_LDB(B1, 1, 1); PG8_SCHED; PG8_LDA(At, 1, 0); PG8_STAGE(PG8_SA(0, 1), a2 + hstep, voffA);
            PG8_WAIT_V(8); PG8_WAIT_L(0); PG8_BAR; PG8_MMA(0, 0, At, B0); PG8_MMA(0, 1, At, B1); PG8_BAR; PG8_SCHED;
            PG8_LDA(At, 1, 1); PG8_STAGE(PG8_SB(1, 0), b3, voffB); PG8_STAGE(PG8_SB(1, 1), b3 + hstep, voffB); PG8_STAGE(PG8_SA(1, 0), a3, voffA);
            PG8_WAIT_V(8); PG8_WAIT_L(0); PG8_BAR; PG8_MMA(1, 0, At, B0); PG8_MMA(1, 1, At, B1); PG8_BAR; PG8_SCHED;
            } else {
            PG8_LDB(B0, 0, 0); PG8_SCHED; PG8_LDA(At, 0, 0); PG8_STAGE(PG8_SA(1, 1), a1 + hstep, voffA);
            PG8_WAIT_L(8); PG8_BAR; PG8_WAIT_L(0); PG8_MMA(0, 0, At, B0); PG8_BAR; PG8_SCHED;
            PG8_LDB(B1, 0, 1); PG8_STAGE(PG8_SB(0, 0), b2, voffB);
            PG8_BAR; PG8_WAIT_L(0); PG8_MMA(0, 1, At, B1); PG8_BAR;
            PG8_LDA(At, 0, 1); PG8_STAGE(PG8_SA(0, 0), a2, voffA);
            PG8_BAR; PG8_WAIT_L(0); PG8_MMA(1, 0, At, B0); PG8_BAR; PG8_SCHED;
            PG8_STAGE(PG8_SB(0, 1), b2 + hstep, voffB);
            PG8_WAIT_V(6); PG8_BAR; PG8_MMA(1, 1, At, B1); PG8_BAR;
            PG8_LDB(B0, 1, 0); PG8_SCHED; PG8_LDA(At, 1, 0); PG8_STAGE(PG8_SA(0, 1), a2 + hstep, voffA);
            PG8_WAIT_L(8); PG8_BAR; PG8_WAIT_L(0); PG8_MMA(0, 0, At, B0); PG8_BAR; PG8_SCHED;
            PG8_LDB(B1, 1, 1); PG8_STAGE(PG8_SB(1, 0), b3, voffB);
            PG8_BAR; PG8_WAIT_L(0); PG8_MMA(0, 1, At, B1); PG8_BAR;
            PG8_LDA(At, 1, 1); PG8_STAGE(PG8_SA(1, 0), a3, voffA);
            PG8_BAR; PG8_WAIT_L(0); PG8_MMA(1, 0, At, B0); PG8_BAR; PG8_SCHED;
            PG8_STAGE(PG8_SB(1, 1), b3 + hstep, voffB);
            PG8_WAIT_V(6); PG8_BAR; PG8_MMA(1, 1, At, B1); PG8_BAR;
            }
        }
        if constexpr (ALIGN_EPI) { if (wr == 0) PG8_BAR; }
        if constexpr (!Epi::AFTER_DRAIN) { E(acc, cur, wr, wc, fr, fq); S.done(cur); }
        if (!has_next) break;
#pragma unroll
        for (int a = 0; a < 2; ++a)
#pragma unroll
            for (int b = 0; b < 2; ++b)
#pragma unroll
                for (int m = 0; m < 4; ++m)
#pragma unroll
                    for (int n = 0; n < 2; ++n) acc[a][b][m][n] = (f32x4){0.f, 0.f, 0.f, 0.f};
        cur = nxt; cA = nA; cB = nB; ++ui;
        if constexpr (ALIGN_EPI) { if (wr == 1) PG8_BAR; }
    }
    PG8_WAIT_V(0);
    if constexpr (!ALIGN_EPI) { if (wr == 0) PG8_BAR; }
    PG8_BAR;
    if constexpr (Epi::AFTER_DRAIN) { E.fused(acc, cur, wr, wc, fr, fq, lds, wid, lane); S.done(cur); }
#undef PG8_SA
#undef PG8_SB
#undef PG8_STAGE
#undef PG8_LDA
#undef PG8_LDB
#undef PG8_MMA
#undef PG8_WAIT_V
#undef PG8_WAIT_L
#undef PG8_BAR
#undef PG8_SCHED
}
}

typedef unsigned short bf16;
typedef unsigned v4u __attribute__((ext_vector_type(4)));
typedef float f32x4 __attribute__((ext_vector_type(4)));
#define GAS __attribute__((address_space(1)))
#define LDS_WAIT() asm volatile("s_waitcnt lgkmcnt(0)" ::: "memory")
#define VM_WAIT() asm volatile("s_waitcnt vmcnt(0)" ::: "memory")
__device__ __forceinline__ unsigned f2bf(float f) { unsigned u = __builtin_bit_cast(unsigned, f); return (u + 0x7fffu + ((u >> 16) & 1u)) >> 16; }
__device__ __forceinline__ unsigned pk2(float lo, float hi) { return f2bf(lo) | (f2bf(hi) << 16); }
__device__ __forceinline__ float bf2f(unsigned short v) { return __builtin_bit_cast(float, (unsigned)v << 16); }

struct Frame {
    LAS unsigned char* lds;
    int nvb;
    int wave, G, vcu;
    unsigned* ctl;
    float* modp; bf16* w_in_t; bf16* h1b; bf16* w_out_t; bf16* wr_t; bf16* ws_down_t; bf16* ycatb; bf16* h2b; bf16* sactb; float* rsg; bf16* actb; bf16* contribb; bf16* projb; float* ssq; bf16* qrb; bf16* krb; float* UT; bf16* RT; bf16* x1b;
    const float *x, *c, *w_ada, *b_ada, *w_in, *rel_bias, *attn_gain, *ret_gain, *w_out, *ln1_g, *ln1_b, *w_router, *router_bias, *w_gate, *w_up, *w_down, *ws_gate, *ws_up, *ws_down, *ln2_g, *ln2_b;
    float* out;
    int* counts; float* mod; float* cs; float* h1; float* proj; float* qr; float* kr; float* attn_out; float* U; float* R; float* ycat; float* mixer; float* x1; float* h2;
    float* logits; int* lists; int* a_exp; float* a_w; float* act; float* contrib; float* sgu; float* sact; float* sh_out;
};
#define VB_FOR(u, N) for (int _b = (int)blockIdx.x * 2, u = _b + (F.wave >> 2); _b < (N); _b += (int)gridDim.x * 2, u = _b + (F.wave >> 2))

__device__ __forceinline__ void ph_gemm(Frame& F, const float* __restrict__ A, int lda, const float* __restrict__ B, int ldb, float* __restrict__ C, int ldc, int M, int N, int K) {
    LAS float* As = (LAS float*)(F.lds + (F.wave >> 2) * 16384);
    LAS float* Bs = As + 16 * 68;
    const int tid = ((F.wave & 3) * 64 + lane_id()), tx = tid & 15, ty = tid >> 4, ntn = N / 64, ntiles = (M / 64) * ntn;
    VB_FOR(u, ntiles) {
        const int m0 = (u / ntn) * 64, n0 = (u % ntn) * 64;
        float acc[4][4];
#pragma unroll
        for (int i = 0; i < 4; ++i)
#pragma unroll
            for (int j = 0; j < 4; ++j) acc[i][j] = 0.f;
        for (int k0 = 0; k0 < K; k0 += 16) {
            {
                const int r = tid >> 2, c4 = (tid & 3) * 4;
                const float4 v = *(const float4*)(A + (size_t)(m0 + r) * lda + k0 + c4);
                As[(c4 + 0) * 68 + r] = v.x; As[(c4 + 1) * 68 + r] = v.y; As[(c4 + 2) * 68 + r] = v.z; As[(c4 + 3) * 68 + r] = v.w;
                const int kr = tid >> 4, cc = (tid & 15) * 4;
                const float4 w = *(const float4*)(B + (size_t)(k0 + kr) * ldb + n0 + cc);
                Bs[kr * 68 + cc + 0] = w.x; Bs[kr * 68 + cc + 1] = w.y; Bs[kr * 68 + cc + 2] = w.z; Bs[kr * 68 + cc + 3] = w.w;
            }
            __syncthreads();
#pragma unroll
            for (int kk = 0; kk < 16; ++kk) {
                float a[4], b[4];
#pragma unroll
                for (int i = 0; i < 4; ++i) a[i] = As[kk * 68 + ty * 4 + i];
#pragma unroll
                for (int j = 0; j < 4; ++j) b[j] = Bs[kk * 68 + tx * 4 + j];
#pragma unroll
                for (int i = 0; i < 4; ++i)
#pragma unroll
                    for (int j = 0; j < 4; ++j) acc[i][j] += a[i] * b[j];
            }
            __syncthreads();
        }
#pragma unroll
        for (int i = 0; i < 4; ++i)
#pragma unroll
            for (int j = 0; j < 4; ++j) C[(size_t)(m0 + ty * 4 + i) * ldc + n0 + tx * 4 + j] = acc[i][j];
    }
}

__device__ __forceinline__ void ph_mod_rope(Frame& F) {
    const int gt = (int)blockIdx.x * 512 + (F.wave * 64 + lane_id()), GT = (int)gridDim.x * 512;
    for (int i = gt; i < 2 * 6 * D_MODEL; i += GT) {
        const int b = i / (6 * D_MODEL), n = i % (6 * D_MODEL);
        float acc = 0.f;
        for (int k = 0; k < D_MODEL; ++k) acc += silu_f(F.c[b * D_MODEL + k]) * F.w_ada[(size_t)k * (6 * D_MODEL) + n];
        F.mod[i] = acc + F.b_ada[n];
    }
    for (int i = gt; i < SEQ * 32; i += GT) {
        const int s = i >> 5, j = i & 31;
        const float inv = powf(10000.0f, -(float)j / 32.0f);
        const float ang = (float)s * inv;
        F.cs[2 * i] = cosf(ang); F.cs[2 * i + 1] = sinf(ang);
    }
}
__device__ __forceinline__ void ph_modulate(Frame& F) {
    const size_t gt = (size_t)blockIdx.x * 512 + (F.wave * 64 + lane_id()), GT = (size_t)gridDim.x * 512;
    for (size_t i = gt; i < (size_t)NTOK * D_MODEL; i += GT) {
        const int t = (int)(i / D_MODEL), d = (int)(i % D_MODEL), b = t / SEQ;
        F.h1[i] = F.x[i] * (1.0f + F.mod[b * 6 * D_MODEL + D_MODEL + d]) + F.mod[b * 6 * D_MODEL + d];
    }
}
__device__ __forceinline__ void ph_band_attn(Frame& F) {
    const float* __restrict__ proj = F.proj;
    VB_FOR(u, 1024) {
        const int c = u & 63, h = (u >> 6) & 7, b = u >> 9;
        const int tid = ((F.wave & 3) * 64 + lane_id()), i = tid >> 2, part = tid & 3;
        const size_t tq = (size_t)b * SEQ + c * 64 + i;
        float q[32], o[32];
        const float scale = 0.08838834764831845f;
#pragma unroll
        for (int d = 0; d < 32; ++d) { q[d] = proj[tq * IN_WIDTH + h * 128 + part * 32 + d] * scale; o[d] = 0.f; }
        float m = -1e30f, l = 0.f;
        for (int j = 0; j < 576; ++j) {
            const int kpos = c * 64 - 512 + j;
            if (kpos < 0) continue;
            const size_t tk = (size_t)b * SEQ + kpos;
            const float* kp = proj + tk * IN_WIDTH + 1024 + h * 128 + part * 32;
            float s = 0.f;
#pragma unroll
            for (int d = 0; d < 32; ++d) s += q[d] * kp[d];
            s += __shfl_xor(s, 1); s += __shfl_xor(s, 2);
            int dist = 512 + i - j; dist = dist < -63 ? -63 : (dist > 256 ? 256 : dist);
            s += F.rel_bias[h * 320 + dist + 63];
            const float mn = fmaxf(m, s), a = __expf(m - mn), p = __expf(s - mn);
            l = l * a + p; m = mn;
            const float* vp = proj + tk * IN_WIDTH + 2048 + h * 128 + part * 32;
#pragma unroll
            for (int d = 0; d < 32; ++d) o[d] = o[d] * a + p * vp[d];
        }
        const float il = 1.0f / l;
#pragma unroll
        for (int d = 0; d < 32; ++d) F.attn_out[tq * 1024 + h * 128 + part * 32 + d] = o[d] * il;
    }
}
__device__ __forceinline__ void ph_rot(Frame& F) {
    const size_t gt = (size_t)blockIdx.x * 512 + (F.wave * 64 + lane_id()), GT = (size_t)gridDim.x * 512;
    for (size_t i = gt; i < (size_t)NTOK * 256; i += GT) {
        const int j = (int)(i & 31), h = (int)((i >> 5) & 7); const size_t t = i >> 8; const int s = (int)(t % SEQ);
        const float co = F.cs[(s * 32 + j) * 2], si = F.cs[(s * 32 + j) * 2 + 1];
        const bf16* pq = F.projb + t * IN_WIDTH + 3072 + h * 64; const bf16* pk = F.projb + t * IN_WIDTH + 3584 + h * 64;
        const float q1 = bf2f(pq[j]), q2 = bf2f(pq[j + 32]), k1 = bf2f(pk[j]), k2 = bf2f(pk[j + 32]);
        F.qr[t * 512 + h * 64 + j] = q1 * co - q2 * si; F.qr[t * 512 + h * 64 + 32 + j] = q2 * co + q1 * si;
        F.kr[t * 512 + h * 64 + j] = (k1 * co - k2 * si) * 0.125f; F.kr[t * 512 + h * 64 + 32 + j] = (k2 * co + k1 * si) * 0.125f;
    }
}
__device__ __forceinline__ void ph_rms(Frame& F) {
    const int lane = (F.wave * 64 + lane_id()) & 63, gw = (int)blockIdx.x * 8 + ((F.wave * 64 + lane_id()) >> 6), GW = (int)gridDim.x * 8;
    for (int t = gw; t < NTOK; t += GW) {
        float v[16]; float ss = 0.f;
#pragma unroll
        for (int j = 0; j < 16; ++j) { v[j] = F.attn_out[(size_t)t * 1024 + lane + 64 * j]; ss += v[j] * v[j]; }
        for (int o = 32; o > 0; o >>= 1) ss += __shfl_xor(ss, o);
        const float rs = rsqrtf(ss / 1024.0f + EPS_F);
#pragma unroll
        for (int j = 0; j < 16; ++j) F.ycatb[(size_t)t * D_MODEL + lane + 64 * j] = (bf16)f2bf(v[j] * rs * F.attn_gain[lane + 64 * j]);
    }
}
__device__ __forceinline__ void ph_ret_u(Frame& F) {
    VB_FOR(u, 1024) {
        const int c = u & 63, h = (u >> 6) & 7, b = u >> 9, tid = ((F.wave & 3) * 64 + lane_id()), kk = tid >> 2, part = tid & 3;
        const float lg = log_gamma(h);
        float acc[32];
#pragma unroll
        for (int d = 0; d < 32; ++d) acc[d] = 0.f;
        for (int m = 0; m < 64; ++m) {
            const size_t t = (size_t)b * SEQ + c * 64 + m;
            const float kv = F.kr[t * 512 + h * 64 + kk] * __expf(lg * (float)(63 - m));
            const bf16* vp = F.projb + t * IN_WIDTH + 4096 + h * 128 + part * 32;
#pragma unroll
            for (int d = 0; d < 32; ++d) acc[d] += kv * bf2f(vp[d]);
        }
        float* up = F.U + ((((size_t)b * 8 + h) * 64 + c) * 64 + kk) * 128 + part * 32;
#pragma unroll
        for (int d = 0; d < 32; ++d) up[d] = acc[d];
    }
}
__device__ __forceinline__ void ph_ret_scan(Frame& F) {
    const int gt = (int)blockIdx.x * 512 + (F.wave * 64 + lane_id()), GT = (int)gridDim.x * 512;
    for (int i = gt; i < 2 * 8 * 8192; i += GT) {
        const int e = i & 8191, bh = i >> 13, h = bh & 7;
        const float g = __expf(log_gamma(h) * 64.0f);
        float st = 0.f;
        for (int c = 0; c < 64; ++c) { const size_t o = ((size_t)bh * 64 + c) * 8192 + e; F.R[o] = st; st = g * st + F.U[o]; }
    }
}
__device__ __forceinline__ void ph_ret_out(Frame& F) {
    VB_FOR(u, 1024) {
        const int c = u & 63, h = (u >> 6) & 7, b = u >> 9, tid = ((F.wave & 3) * 64 + lane_id()), n = tid >> 2, part = tid & 3;
        const float lg = log_gamma(h);
        const size_t tn = (size_t)b * SEQ + c * 64 + n;
        float q[16], o[32];
#pragma unroll
        for (int d = 0; d < 16; ++d) q[d] = F.qr[tn * 512 + h * 64 + part * 16 + d];
#pragma unroll
        for (int d = 0; d < 32; ++d) o[d] = 0.f;
        for (int m = 0; m < 64; ++m) {
            const size_t tm = (size_t)b * SEQ + c * 64 + m;
            const float* kp = F.kr + tm * 512 + h * 64 + part * 16;
            float s = 0.f;
#pragma unroll
            for (int d = 0; d < 16; ++d) s += q[d] * kp[d];
            s += __shfl_xor(s, 1); s += __shfl_xor(s, 2);
            const int dd = n > m ? n - m : m - n;
            s *= __expf(lg * (float)dd);
            const bf16* vp = F.projb + tm * IN_WIDTH + 4096 + h * 128 + part * 32;
#pragma unroll
            for (int d = 0; d < 32; ++d) o[d] += s * bf2f(vp[d]);
        }
        const float xi = __expf(lg * (float)(n + 1));
        const float* Rp = F.R + (((size_t)b * 8 + h) * 64 + c) * 8192;
        for (int kk = 0; kk < 64; ++kk) {
            const float qv = F.qr[tn * 512 + h * 64 + kk] * xi;
            const float* rp = Rp + kk * 128 + part * 32;
#pragma unroll
            for (int d = 0; d < 32; ++d) o[d] += qv * rp[d];
        }
        float s1 = 0.f;
#pragma unroll
        for (int d = 0; d < 32; ++d) s1 += o[d];
        s1 += __shfl_xor(s1, 1); s1 += __shfl_xor(s1, 2);
        const float mu = s1 / 128.0f; float s2 = 0.f;
#pragma unroll
        for (int d = 0; d < 32; ++d) { const float dv = o[d] - mu; s2 += dv * dv; }
        s2 += __shfl_xor(s2, 1); s2 += __shfl_xor(s2, 2);
        const float rs = rsqrtf(s2 / 128.0f + EPS_F);
#pragma unroll
        for (int d = 0; d < 32; ++d) {
            const int col = h * 128 + part * 32 + d;
            const float gb = bf2f(F.projb[tn * IN_WIDTH + 5120 + col]);
            F.ycatb[tn * D_MODEL + 1024 + col] = (bf16)f2bf(silu_f(gb) * (o[d] - mu) * rs * F.ret_gain[col]);
        }
    }
}
__device__ __forceinline__ void ph_res_ln(Frame& F, const float* __restrict__ xres, const float* __restrict__ y, const bf16* __restrict__ contrib, int g_off,
                                          const float* __restrict__ gain, const float* __restrict__ bias, float* __restrict__ xo, int sh_off, int sc_off, float* __restrict__ hmod) {
    const int lane = (F.wave * 64 + lane_id()) & 63, gw = (int)blockIdx.x * 8 + ((F.wave * 64 + lane_id()) >> 6), GW = (int)gridDim.x * 8;
    for (int t = gw; t < NTOK; t += GW) {
        const int b = t / SEQ;
        float z[32]; float s = 0.f;
#pragma unroll
        for (int j = 0; j < 32; ++j) {
            const int d = lane + 64 * j; float yy = y[(size_t)t * D_MODEL + d];
            if (contrib) {
#pragma unroll
                for (int k = 0; k < 8; ++k) yy += bf2f(contrib[((size_t)t * 8 + k) * D_MODEL + d]);
            }
            z[j] = ALPHA_F * xres[(size_t)t * D_MODEL + d] + F.mod[b * 6 * D_MODEL + g_off + d] * yy; s += z[j];
        }
        for (int o = 32; o > 0; o >>= 1) s += __shfl_xor(s, o);
        const float mu = s / (float)D_MODEL; float q = 0.f;
#pragma unroll
        for (int j = 0; j < 32; ++j) { const float dv = z[j] - mu; q += dv * dv; }
        for (int o = 32; o > 0; o >>= 1) q += __shfl_xor(q, o);
        const float rs = rsqrtf(q / (float)D_MODEL + EPS_F);
#pragma unroll
        for (int j = 0; j < 32; ++j) {
            const int d = lane + 64 * j; const float v = (z[j] - mu) * rs * gain[d] + bias[d];
            xo[(size_t)t * D_MODEL + d] = v;
            if (hmod) { const float hv = v * (1.0f + F.mod[b * 6 * D_MODEL + sc_off + d]) + F.mod[b * 6 * D_MODEL + sh_off + d]; hmod[(size_t)t * D_MODEL + d] = hv; F.h2b[(size_t)t * D_MODEL + d] = (bf16)f2bf(hv); }
        }
    }
}
__device__ __forceinline__ void ph_route(Frame& F) {
    LAS float* sb = (LAS float*)(F.lds + (F.wave >> 2) * 4096); LAS float* ssc = sb + 256; LAS float* gs = ssc + 256; LAS int* gsel = (LAS int*)(gs + 8); LAS int* pick = gsel + 8;
    const int e = ((F.wave & 3) * 64 + lane_id());
    VB_FOR(t, NTOK) {
        const float sc = sigmoid_f(F.rsg[(size_t)t * 768 + e]); const float bi = sc + F.router_bias[e];
        __syncthreads();
        ssc[e] = sc; sb[e] = bi;
        __syncthreads();
        if (e < 8) { float t1 = -1e30f, t2 = -1e30f; for (int i = 0; i < 32; ++i) { const float v = sb[e * 32 + i]; if (v > t1) { t2 = t1; t1 = v; } else if (v > t2) t2 = v; } gs[e] = t1 + t2; gsel[e] = 0; }
        __syncthreads();
        if (e == 0) {
            for (int r = 0; r < 4; ++r) { int bi_ = 0; float bv = -1e30f; for (int g = 0; g < 8; ++g) if (!gsel[g] && gs[g] > bv) { bv = gs[g]; bi_ = g; } gsel[bi_] = 1; }
        }
        __syncthreads();
        if (!gsel[e >> 5]) sb[e] = -1e30f;
        __syncthreads();
        if (e == 0) {
            float wsum = 0.f;
            for (int r = 0; r < 8; ++r) { int bi_ = 0; float bv = -2e30f; for (int i = 0; i < 256; ++i) if (sb[i] > bv) { bv = sb[i]; bi_ = i; } pick[r] = bi_; sb[bi_] = -3e30f; wsum += ssc[bi_]; }
            for (int r = 0; r < 8; ++r) {
                const int ex = pick[r]; const int slot = atomicAdd(&F.counts[ex], 1);
                F.lists[ex * NTOK + slot] = t * 8 + r; F.a_exp[t * 8 + r] = ex; F.a_w[t * 8 + r] = ssc[ex] / wsum * 2.5f;
            }
        }
    }
}
__device__ __forceinline__ void ph_swiglu_act(Frame& F) {
    const size_t gt = (size_t)blockIdx.x * 512 + (F.wave * 64 + lane_id()), GT = (size_t)gridDim.x * 512;
    for (size_t i = gt; i < (size_t)NTOK * 256; i += GT) { const size_t t = i >> 8; const int j = (int)(i & 255); F.sactb[i] = (bf16)f2bf(silu_f(F.rsg[t * 768 + 256 + j]) * F.rsg[t * 768 + 512 + j]); }
}
__device__ __forceinline__ void ph_moe_gu(Frame& F) {
    LAS float* hs = (LAS float*)(F.lds + (F.wave >> 2) * 8192);
    const int j = ((F.wave & 3) * 64 + lane_id());
    for (int e = blockIdx.x; e < NEXP; e += gridDim.x) {
        const int cnt = F.counts[e];
        const float* wgp = F.w_gate + (size_t)e * D_MODEL * EDIM; const float* wup = F.w_up + (size_t)e * D_MODEL * EDIM;
        for (int t0 = 0; t0 < cnt; t0 += 16) {
            const int tile0 = t0 + (F.wave >> 2) * 8;
            int aid[8];
#pragma unroll
            for (int i = 0; i < 8; ++i) { const int s = tile0 + i; aid[i] = s < cnt ? F.lists[e * NTOK + s] : -1; }
            float ag[8], au[8];
#pragma unroll
            for (int i = 0; i < 8; ++i) { ag[i] = 0.f; au[i] = 0.f; }
            for (int k0 = 0; k0 < D_MODEL; k0 += 256) {
                __syncthreads();
#pragma unroll
                for (int i = 0; i < 8; ++i) hs[i * 256 + j] = aid[i] >= 0 ? F.h2[(size_t)(aid[i] >> 3) * D_MODEL + k0 + j] : 0.f;
                __syncthreads();
                for (int kk = 0; kk < 256; ++kk) {
                    const float a = wgp[(size_t)(k0 + kk) * EDIM + j], u = wup[(size_t)(k0 + kk) * EDIM + j];
#pragma unroll
                    for (int i = 0; i < 8; ++i) { const float hv = hs[i * 256 + kk]; ag[i] += hv * a; au[i] += hv * u; }
                }
            }
#pragma unroll
            for (int i = 0; i < 8; ++i) if (aid[i] >= 0) F.act[(size_t)aid[i] * EDIM + j] = silu_f(ag[i]) * au[i];
        }
    }
}
__device__ __forceinline__ void ph_moe_down(Frame& F) {
    LAS float* as = (LAS float*)(F.lds + (F.wave >> 2) * 8192);
    const int j = ((F.wave & 3) * 64 + lane_id());
    for (int e = blockIdx.x; e < NEXP; e += gridDim.x) {
        const int cnt = F.counts[e];
        for (int t0 = 0; t0 < cnt; t0 += 16) {
            const int tile0 = t0 + (F.wave >> 2) * 8;
            int aid[8];
#pragma unroll
            for (int i = 0; i < 8; ++i) { const int s = tile0 + i; aid[i] = s < cnt ? F.lists[e * NTOK + s] : -1; }
            __syncthreads();
#pragma unroll
            for (int i = 0; i < 8; ++i) as[i * 256 + j] = aid[i] >= 0 ? F.act[(size_t)aid[i] * EDIM + j] : 0.f;
            __syncthreads();
            for (int half = 0; half < 2; ++half) {
                float acc[4][8];
#pragma unroll
                for (int c = 0; c < 4; ++c)
#pragma unroll
                    for (int i = 0; i < 8; ++i) acc[c][i] = 0.f;
                const float* wp = F.w_down + (size_t)e * EDIM * D_MODEL + half * 1024 + j;
                for (int kk = 0; kk < 256; ++kk) {
                    float w[4];
#pragma unroll
                    for (int c = 0; c < 4; ++c) w[c] = wp[(size_t)kk * D_MODEL + 256 * c];
#pragma unroll
                    for (int i = 0; i < 8; ++i) { const float a = as[i * 256 + kk];
#pragma unroll
                        for (int c = 0; c < 4; ++c) acc[c][i] += a * w[c]; }
                }
#pragma unroll
                for (int i = 0; i < 8; ++i) if (aid[i] >= 0) { const float rw = F.a_w[aid[i]];
#pragma unroll
                    for (int c = 0; c < 4; ++c) F.contrib[(size_t)aid[i] * D_MODEL + half * 1024 + j + 256 * c] = rw * acc[c][i]; }
            }
        }
    }
}


__device__ __forceinline__ float wave_sum(float v) {
#pragma unroll
    for (int o = 1; o < 64; o <<= 1) v += __shfl_xor(v, o);
    return v;
}
__device__ __forceinline__ void p0_transpose_item(const float* W, int K, int N, bf16* WT, int row_off, LAS float* scr, int item, int lane) {
    const int nblk = N / 32, kb = item / nblk, nb = item % nblk, k0 = 64 * kb, n0 = 32 * nb;
#pragma unroll 8
    for (int i = 0; i < 32; ++i) { const int kk = 2 * i + (lane >> 5); scr[kk * 33 + (lane & 31)] = W[(size_t)(k0 + kk) * N + n0 + (lane & 31)]; }
    LDS_WAIT(); asm volatile("" ::: "memory");
    const int c = lane & 7;
#pragma unroll
    for (int j = 0; j < 4; ++j) { const int n = (lane >> 3) + 8 * j; const LAS float* s = scr + (8 * c) * 33 + n;
        v4u o; o.x = pk2(s[0 * 33], s[1 * 33]); o.y = pk2(s[2 * 33], s[3 * 33]); o.z = pk2(s[4 * 33], s[5 * 33]); o.w = pk2(s[6 * 33], s[7 * 33]);
        *(GAS v4u*)(WT + (size_t)(row_off + n0 + n) * K + k0 + 8 * c) = o; }
    LDS_WAIT(); asm volatile("" ::: "memory");
}
constexpr int CW_MODCNT = 12288;
__device__ __forceinline__ void p0_mod(Frame& F) {
    LAS float* red = (LAS float*)F.lds;
    volatile LAS unsigned* flag = (volatile LAS unsigned*)(F.lds + 65536);
    for (int p = blockIdx.x; p < 256; p += gridDim.x) {
        const int kr = p >> 4, cb = p & 15;
        f32x4 acc[2][3];
#pragma unroll
        for (int b = 0; b < 2; ++b)
#pragma unroll
            for (int j = 0; j < 3; ++j) acc[b][j] = (f32x4){0.f, 0.f, 0.f, 0.f};
        const int kbase = kr * 128 + F.wave * 16;
#pragma unroll 4
        for (int i = 0; i < 16; ++i) {
            const int k = kbase + i;
            const float s0 = silu_f(F.c[k]), s1 = silu_f(F.c[D_MODEL + k]);
            const float* wp = F.w_ada + (size_t)k * (6 * D_MODEL) + cb * 768 + lane_id() * 4;
#pragma unroll
            for (int j = 0; j < 3; ++j) { const f32x4 w = *(const f32x4*)(wp + j * 256); acc[0][j] += w * s0; acc[1][j] += w * s1; }
        }
        __syncthreads();
#pragma unroll
        for (int b = 0; b < 2; ++b)
#pragma unroll
            for (int j = 0; j < 3; ++j) *(LAS f32x4*)(red + (F.wave * 2 + b) * 768 + j * 256 + lane_id() * 4) = acc[b][j];
        __syncthreads();
        for (int o = (F.wave * 64 + lane_id()); o < 1536; o += 512) {
            const int b = o / 768, n = o % 768; float s = 0.f;
#pragma unroll
            for (int w = 0; w < 8; ++w) s += red[(w * 2 + b) * 768 + n];
            F.modp[((size_t)kr * 2 + b) * (6 * D_MODEL) + cb * 768 + n] = s;
        }
        asm volatile("s_waitcnt vmcnt(0)" ::: "memory");
        __syncthreads();
        if ((F.wave * 64 + lane_id()) == 0) {
            __builtin_amdgcn_fence(__ATOMIC_RELEASE, "agent");
            asm volatile("s_waitcnt vmcnt(0)" ::: "memory");
            const unsigned old = __hip_atomic_fetch_add(F.ctl + CW_MODCNT + 64 * cb, 1u, __ATOMIC_RELAXED, __HIP_MEMORY_SCOPE_AGENT);
            const unsigned last = (old == 15u) ? 1u : 0u;
            if (last) { __builtin_amdgcn_fence(__ATOMIC_ACQUIRE, "agent"); asm volatile("s_waitcnt vmcnt(0)" ::: "memory"); }
            flag[0] = last;
        }
        __syncthreads();
        if (flag[0]) {
            for (int o = (F.wave * 64 + lane_id()); o < 1536; o += 512) {
                const int b = o / 768, n = cb * 768 + o % 768; float s = F.b_ada[n];
#pragma unroll
                for (int r = 0; r < 16; ++r) s += F.modp[((size_t)r * 2 + b) * (6 * D_MODEL) + n];
                F.mod[b * 6 * D_MODEL + n] = s;
            }
        }
        __syncthreads();
    }
}
__device__ __forceinline__ void p0_prologue(Frame& F) {
    p0_mod(F);
    { const int gt = (int)blockIdx.x * 512 + (F.wave * 64 + lane_id()), GT = (int)gridDim.x * 512;
      for (int i = gt; i < SEQ * 32; i += GT) { const int s = i >> 5, j = i & 31; const float inv = powf(10000.0f, -(float)j / 32.0f); const float ang = (float)s * inv; F.cs[2 * i] = cosf(ang); F.cs[2 * i + 1] = sinf(ang); } }
    __syncthreads();
    LAS float* scr = (LAS float*)(F.lds + F.wave * 16384);
    const int gw = F.vcu * 8 + F.wave, NGW = F.G * 8;
    constexpr int I_IN = (D_MODEL / 64) * (IN_WIDTH / 32);
    constexpr int I_OUT = (D_MODEL / 64) * (D_MODEL / 32), I_R = (D_MODEL / 64) * (256 / 32), I_D = (256 / 64) * (D_MODEL / 32);
    constexpr int NITEMS = I_IN + I_OUT + 3 * I_R + I_D;
    for (int it = gw; it < NITEMS; it += NGW) {
        int r = it;
        if (r < I_IN) { p0_transpose_item(F.w_in, D_MODEL, IN_WIDTH, F.w_in_t, 0, scr, r, lane_id()); continue; } r -= I_IN;
        if (r < I_OUT) { p0_transpose_item(F.w_out, D_MODEL, D_MODEL, F.w_out_t, 0, scr, r, lane_id()); continue; } r -= I_OUT;
        if (r < I_R) { p0_transpose_item(F.w_router, D_MODEL, 256, F.wr_t, 0, scr, r, lane_id()); continue; } r -= I_R;
        if (r < I_R) { p0_transpose_item(F.ws_gate, D_MODEL, 256, F.wr_t, 256, scr, r, lane_id()); continue; } r -= I_R;
        if (r < I_R) { p0_transpose_item(F.ws_up, D_MODEL, 256, F.wr_t, 512, scr, r, lane_id()); continue; } r -= I_R;
        p0_transpose_item(F.ws_down, 256, D_MODEL, F.ws_down_t, 0, scr, r, lane_id());
    }
}
__device__ __forceinline__ void p1_modulate_bf16(Frame& F) {
    const size_t gt = (size_t)blockIdx.x * 512 + (F.wave * 64 + lane_id()), GT = (size_t)gridDim.x * 512;
    for (size_t i = gt; i < (size_t)NTOK * D_MODEL / 8; i += GT) {
        const size_t e = i * 8; const int t = (int)(e / D_MODEL), d = (int)(e % D_MODEL), b = t / SEQ;
        const f32x4 x0 = *(const f32x4*)(F.x + e), x1 = *(const f32x4*)(F.x + e + 4);
        const float* mb = F.mod + b * 6 * D_MODEL;
        const f32x4 sh0 = *(const f32x4*)(mb + d), sh1 = *(const f32x4*)(mb + d + 4), sc0 = *(const f32x4*)(mb + D_MODEL + d), sc1 = *(const f32x4*)(mb + D_MODEL + d + 4);
        const f32x4 h0 = x0 * (sc0 + 1.0f) + sh0, h1 = x1 * (sc1 + 1.0f) + sh1;
        v4u o; o.x = pk2(h0[0], h0[1]); o.y = pk2(h0[2], h0[3]); o.z = pk2(h1[0], h1[1]); o.w = pk2(h1[2], h1[3]);
        *(v4u*)(F.h1b + e) = o;
    }
}

typedef float f32x16 __attribute__((ext_vector_type(16)));
typedef short bf16x8 __attribute__((ext_vector_type(8)));
constexpr int MOE_MC = 384, MOE_ABUF = MOE_MC * 128, MOE_BBUF = 128 * 128;
constexpr int MOE_TAB = 131072 + 1024;
#define MOE_WAITV(n) asm volatile("s_waitcnt vmcnt(" #n ")" ::: "memory")

__device__ __forceinline__ void moe_tables(Frame& F) {
    LAS int* cnt = (LAS int*)(F.lds + MOE_TAB); LAS int* order = cnt + 256; LAS int* offs = order + 256;
    __syncthreads();
    if ((F.wave * 64 + lane_id()) < 256) cnt[(F.wave * 64 + lane_id())] = F.counts[(F.wave * 64 + lane_id())];
    __syncthreads();
    if ((F.wave * 64 + lane_id()) < 256) {
        const int me = cnt[(F.wave * 64 + lane_id())]; int rank = 0, pre = 0;
        for (int j = 0; j < 256; ++j) { const int cj = cnt[j]; rank += (cj > me || (cj == me && j < (F.wave * 64 + lane_id()))) ? 1 : 0; pre += (j < (F.wave * 64 + lane_id())) ? cj : 0; }
        order[rank] = (F.wave * 64 + lane_id()); offs[(F.wave * 64 + lane_id())] = pre;
    }
    __syncthreads();
}

template <int MODE>
__device__ __forceinline__ void moe_job(Frame& F, const int e, const int slice, const int chunk_base, const int nrows, const int row_off) {
    constexpr int PER = MODE ? 4 : 32, T = MODE ? 16 : 32;
    const int l = lane_id(), w = F.wave, half = w >> 2, cp = w & 1, rg = w >> 1, h = l >> 5;
    const int nrb = (nrows + 31) >> 5;
    const int my_n = (nrb > rg) ? ((nrb - rg + 3) >> 2) : 0;
    LAS unsigned char* lds = F.lds;
    unsigned aoff[6];
    const unsigned char* abase = MODE ? (const unsigned char*)F.actb : (const unsigned char*)F.h2b;
#pragma unroll
    for (int j = 0; j < 6; ++j) {
        const int r = (w * 6 + j) * 8 + (l >> 3); const int rr = r < nrows ? r : nrows - 1;
        unsigned rowbyte;
        if (MODE == 0) { const int tok = F.lists[e * NTOK + chunk_base + rr] >> 3; rowbyte = (unsigned)tok * (D_MODEL * 2); }
        else rowbyte = (unsigned)(row_off + chunk_base + rr) * (EDIM * 2);
        aoff[j] = rowbyte + (unsigned)(((l & 7) ^ (r & 7)) << 4);
    }
    const int hl = (F.wave * 64 + lane_id()) & 255, cq = hl & 31, kg = hl >> 5;
    const float* bptr; unsigned bld;
    int ncol0;
    if (MODE == 0) { const int seg = cq >> 4, within = (cq & 15) * 4; bptr = (seg ? F.w_up : F.w_gate) + (size_t)e * D_MODEL * EDIM + (size_t)(kg * 8) * EDIM + 64 * slice + within; bld = EDIM;
                     ncol0 = ((within >> 5) * 2 + seg) * 32 + (within & 31); }
    else { bptr = F.w_down + (size_t)e * EDIM * D_MODEL + (size_t)(kg * 8) * D_MODEL + 512 * slice + cq * 4; bld = D_MODEL; ncol0 = cq * 4; }
    f32x4 breg[8];
#define MOE_ISSUE_B(tau) do { const int _sp = (tau) / PER, _kt = (tau) % PER; const float* _p = bptr + (size_t)_kt * 64 * bld + (MODE ? 128 * _sp : 0); \
        _Pragma("unroll") for (int _j = 0; _j < 8; ++_j) breg[_j] = *(const f32x4*)(_p + (size_t)_j * bld); } while (0)
#define MOE_ISSUE_A(tau) do { const unsigned _k = (unsigned)(((tau) % PER) * 128); LAS unsigned char* _d = lds + ((tau) & 1) * MOE_ABUF + w * 6144; \
        _Pragma("unroll") for (int _j = 0; _j < 6; ++_j) __builtin_amdgcn_global_load_lds((const unsigned*)(abase + aoff[_j] + _k), (LAS unsigned*)(_d + _j * 1024), 16, 0, 0); } while (0)
    f32x16 acc[3][2];
#pragma unroll
    for (int i = 0; i < 3; ++i)
#pragma unroll
        for (int c = 0; c < 2; ++c)
#pragma unroll
            for (int q = 0; q < 16; ++q) acc[i][c][q] = 0.f;
    const int fsw = l & 7;
    const unsigned boff = (unsigned)(2 * MOE_ABUF + (cp * 64 + (l & 31)) * 128), toff = (unsigned)((rg * 32 + (l & 31)) * 128);
    __syncthreads();
    MOE_ISSUE_A(0);
    asm volatile("" ::: "memory");
    if (half == 0) MOE_ISSUE_B(0);
    if (half == 1) MOE_ISSUE_B(1);
    asm volatile("" ::: "memory");
    for (int tau = 0; tau < T; ++tau) {
        const bool loader = (half == (tau & 1));
        if (loader) {
            LAS unsigned char* bb = lds + 2 * MOE_ABUF + (tau & 1) * MOE_BBUF;
#pragma unroll
            for (int i = 0; i < 4; ++i) {
                const int n = ncol0 + i;
                v4u o; o.x = pg8::cvt_pk_bf16(breg[0][i], breg[1][i]); o.y = pg8::cvt_pk_bf16(breg[2][i], breg[3][i]); o.z = pg8::cvt_pk_bf16(breg[4][i], breg[5][i]); o.w = pg8::cvt_pk_bf16(breg[6][i], breg[7][i]);
                *(LAS v4u*)(bb + n * 128 + ((kg ^ (n & 7)) << 4)) = o;
            }
            MOE_WAITV(0);
        } else {
            if (tau + 1 < T) MOE_WAITV(8); else MOE_WAITV(0);
        }
        asm volatile("s_waitcnt lgkmcnt(0)" ::: "memory");
        __builtin_amdgcn_s_barrier();
        asm volatile("" ::: "memory");
        if (tau + 1 < T) MOE_ISSUE_A(tau + 1);
        asm volatile("" ::: "memory");
        if (loader && tau + 2 < T) MOE_ISSUE_B(tau + 2);
        asm volatile("" ::: "memory");
        {
            const LAS unsigned char* ab = lds + (tau & 1) * MOE_ABUF + toff;
            const LAS unsigned char* bb = lds + (tau & 1) * MOE_BBUF + boff;
#pragma unroll
            for (int s = 0; s < 4; ++s) {
                const int co = ((2 * s + h) ^ fsw) << 4;
                const bf16x8 w0 = *(const LAS bf16x8*)(bb + co), w1 = *(const LAS bf16x8*)(bb + 32 * 128 + co);
#pragma unroll
                for (int i = 0; i < 3; ++i) if (i < my_n) {
                    const bf16x8 tf = *(const LAS bf16x8*)(ab + i * (4 * 32 * 128) + co);
                    acc[i][0] = __builtin_amdgcn_mfma_f32_32x32x16_bf16(w0, tf, acc[i][0], 0, 0, 0);
                    acc[i][1] = __builtin_amdgcn_mfma_f32_32x32x16_bf16(w1, tf, acc[i][1], 0, 0, 0);
                }
            }
        }
        if ((tau % PER) == PER - 1) {
            const int sp = tau / PER;
#pragma unroll
            for (int i = 0; i < 3; ++i) if (i < my_n) {
                const int R = (rg + 4 * i) * 32 + (l & 31); const bool valid = R < nrows;
                if (MODE == 0) {
                    bf16* dst = F.actb + (size_t)(row_off + chunk_base + R) * EDIM + 64 * slice + 32 * cp + 4 * h;
#pragma unroll
                    for (int g = 0; g < 4; ++g) {
                        float v[4];
#pragma unroll
                        for (int j = 0; j < 4; ++j) v[j] = silu_f(acc[i][0][4 * g + j]) * acc[i][1][4 * g + j];
                        uint2 o; o.x = pg8::cvt_pk_bf16(v[0], v[1]); o.y = pg8::cvt_pk_bf16(v[2], v[3]);
                        if (valid) *(uint2*)(dst + 8 * g) = o;
                    }
                } else {
                    const int aid = F.lists[e * NTOK + chunk_base + (valid ? R : 0)]; const float wt = F.a_w[aid];
                    bf16* dst = F.contribb + (size_t)aid * D_MODEL + 512 * slice + 128 * sp + cp * 64 + 4 * h;
#pragma unroll
                    for (int c = 0; c < 2; ++c)
#pragma unroll
                        for (int g = 0; g < 4; ++g) {
                            uint2 o; o.x = pg8::cvt_pk_bf16(acc[i][c][4 * g] * wt, acc[i][c][4 * g + 1] * wt); o.y = pg8::cvt_pk_bf16(acc[i][c][4 * g + 2] * wt, acc[i][c][4 * g + 3] * wt);
                            if (valid) *(uint2*)(dst + 32 * c + 8 * g) = o;
                        }
                }
            }
#pragma unroll
            for (int i = 0; i < 3; ++i)
#pragma unroll
                for (int c = 0; c < 2; ++c)
#pragma unroll
                    for (int q = 0; q < 16; ++q) acc[i][c][q] = 0.f;
        }
    }
    MOE_WAITV(0);
#undef MOE_ISSUE_A
#undef MOE_ISSUE_B
}
template <int MODE>
__device__ __forceinline__ void moe_stage(Frame& F) {
    moe_tables(F);
    const LAS int* cnt = (const LAS int*)(F.lds + MOE_TAB); const LAS int* order = cnt + 256; const LAS int* offs = order + 256;
    for (int j = blockIdx.x; j < 1024; j += gridDim.x) {
        const int e = order[j >> 2], slice = j & 3, n = cnt[e], ro = offs[e];
        for (int cb = 0; cb < n; cb += MOE_MC) moe_job<MODE>(F, e, slice, cb, (n - cb) < MOE_MC ? (n - cb) : MOE_MC, ro);
    }
    __syncthreads();
}

typedef short s16x4 __attribute__((ext_vector_type(4)));
#define MFMA32(a, b, c) __builtin_amdgcn_mfma_f32_32x32x16_bf16((a), (b), (c), 0, 0, 0)
__device__ __forceinline__ void ph_attn(Frame& F) {
    const int l = lane_id(), w = F.wave, hh = l >> 5, r = l & 31;
    LAS float* biasl = (LAS float*)(F.lds + 81920);
    LAS unsigned char* Vl = F.lds + w * 10240;
    const float LOG2E = 1.4426950408889634f;
    for (int g = blockIdx.x; g < 256; g += gridDim.x) {
        const int bh = g >> 4, b = bh >> 3, h = bh & 7;
        __syncthreads();
        for (int i = (F.wave * 64 + lane_id()); i < 320; i += 512) biasl[i] = F.rel_bias[h * 320 + i] * LOG2E;
        __syncthreads();
        const int c = (g & 15) * 4 + (w >> 1), qh = w & 1;
        const int qrow = c * 64 + qh * 32 + r;
        const bf16* qp = F.projb + (size_t)(b * SEQ + qrow) * IN_WIDTH + h * 128 + 8 * hh;
        bf16x8 qf[8];
#pragma unroll
        for (int s = 0; s < 8; ++s) qf[s] = *(const bf16x8*)(qp + 16 * s);
        f32x16 o[4];
#pragma unroll
        for (int d = 0; d < 4; ++d)
#pragma unroll
            for (int q = 0; q < 16; ++q) o[d][q] = 0.f;
        float m = -1e30f, lsum = 0.f;
        const int kstart = c >= 8 ? (c - 8) * 64 : 0; const int nblk = (c * 64 + 64 - kstart) >> 5;
        const float sscale = 0.08838834764831845f * LOG2E;
        for (int jb = 0; jb < nblk; ++jb) {
            const int kb = kstart + jb * 32;
            const bf16* kp = F.projb + (size_t)(b * SEQ + kb + r) * IN_WIDTH + 1024 + h * 128 + 8 * hh;
            bf16x8 kf[8];
#pragma unroll
            for (int s = 0; s < 8; ++s) kf[s] = *(const bf16x8*)(kp + 16 * s);
            const bf16* vp = F.projb + (size_t)(b * SEQ + kb + (l >> 4)) * IN_WIDTH + 2048 + h * 128 + (l & 15) * 8;
            v4u vr[8];
#pragma unroll
            for (int i = 0; i < 8; ++i) vr[i] = *(const v4u*)(vp + (size_t)i * 4 * IN_WIDTH);
            f32x16 sacc;
#pragma unroll
            for (int q = 0; q < 16; ++q) sacc[q] = 0.f;
#pragma unroll
            for (int s = 0; s < 8; ++s) sacc = MFMA32(kf[s], qf[s], sacc);
#pragma unroll
            for (int i = 0; i < 8; ++i) *(LAS v4u*)(Vl + (4 * i + (l >> 4)) * 320 + (l & 15) * 16) = vr[i];
            float sc[16]; float mx = -1e30f;
#pragma unroll
            for (int q = 0; q < 16; ++q) {
                const int key = (q & 3) + 8 * (q >> 2) + 4 * hh;
                int idx = qrow - (kb + key) + 63; idx = idx > 319 ? 319 : idx;
                sc[q] = sacc[q] * sscale + biasl[idx]; mx = fmaxf(mx, sc[q]);
            }
            mx = fmaxf(mx, __shfl_xor(mx, 32));
            const float mnew = fmaxf(m, mx); const float alpha = __builtin_amdgcn_exp2f(m - mnew); m = mnew;
            float ps = 0.f;
#pragma unroll
            for (int q = 0; q < 16; ++q) { sc[q] = __builtin_amdgcn_exp2f(sc[q] - mnew); ps += sc[q]; }
            lsum = lsum * alpha + ps;
            if (__any(alpha != 1.0f)) {
#pragma unroll
                for (int d = 0; d < 4; ++d) o[d] *= alpha;
            }
            bf16x8 pf[2];
#pragma unroll
            for (int s2 = 0; s2 < 2; ++s2) {
                v4u pk; pk.x = pg8::cvt_pk_bf16(sc[8 * s2 + 0], sc[8 * s2 + 1]); pk.y = pg8::cvt_pk_bf16(sc[8 * s2 + 2], sc[8 * s2 + 3]);
                pk.z = pg8::cvt_pk_bf16(sc[8 * s2 + 4], sc[8 * s2 + 5]); pk.w = pg8::cvt_pk_bf16(sc[8 * s2 + 6], sc[8 * s2 + 7]);
                pf[s2] = __builtin_bit_cast(bf16x8, pk);
            }
            const LAS unsigned char* vt = Vl + (4 * hh + ((l & 15) >> 2)) * 320 + (((l >> 4) & 1) * 16 + 4 * (l & 3)) * 2;
#pragma unroll
            for (int s2 = 0; s2 < 2; ++s2)
#pragma unroll
                for (int db = 0; db < 4; ++db) {
                    const s16x4 t0 = __builtin_amdgcn_ds_read_tr16_b64_v4i16((LAS s16x4*)(vt + (16 * s2) * 320 + db * 64));
                    const s16x4 t1 = __builtin_amdgcn_ds_read_tr16_b64_v4i16((LAS s16x4*)(vt + (16 * s2 + 8) * 320 + db * 64));
                    bf16x8 vf; vf[0] = t0[0]; vf[1] = t0[1]; vf[2] = t0[2]; vf[3] = t0[3]; vf[4] = t1[0]; vf[5] = t1[1]; vf[6] = t1[2]; vf[7] = t1[3];
                    o[db] = MFMA32(vf, pf[s2], o[db]);
                }
        }
        lsum += __shfl_xor(lsum, 32);
        const float inv = 1.0f / lsum;
        const size_t tok = (size_t)b * SEQ + qrow;
        float ssq = 0.f;
#pragma unroll
        for (int db = 0; db < 4; ++db)
#pragma unroll
            for (int gq = 0; gq < 4; ++gq) {
                const int col = h * 128 + db * 32 + 8 * gq + 4 * hh;
                const f32x4 gn = *(const f32x4*)(F.attn_gain + col);
                float v[4];
#pragma unroll
                for (int j = 0; j < 4; ++j) { v[j] = o[db][4 * gq + j] * inv; ssq += v[j] * v[j]; }
                uint2 ov; ov.x = pg8::cvt_pk_bf16(v[0] * gn[0], v[1] * gn[1]); ov.y = pg8::cvt_pk_bf16(v[2] * gn[2], v[3] * gn[3]);
                *(uint2*)(F.ycatb + tok * D_MODEL + col) = ov;
            }
        ssq += __shfl_xor(ssq, 32);
        if (hh == 0) F.ssq[tok * 8 + h] = ssq;
    }
    __syncthreads();
}

__device__ __forceinline__ float lg2_gamma(int h) { return log2f(1.0f - exp2f(-5.0f - (float)h)); }
__device__ __forceinline__ void ph_rot2(Frame& F) {
    const int gt = (int)blockIdx.x * 512 + (F.wave * 64 + lane_id()), GT = (int)gridDim.x * 512;
    for (int i = gt; i < NTOK * 32; i += GT) {
        const int g = i & 3, h = (i >> 2) & 7, t = i >> 5, s = t % SEQ;
        const bf16* pq = F.projb + (size_t)t * IN_WIDTH + 3072 + h * 64 + 8 * g; const bf16* pk = pq + 512;
        const v4u q1 = *(const v4u*)pq, q2 = *(const v4u*)(pq + 32), k1 = *(const v4u*)pk, k2 = *(const v4u*)(pk + 32);
        const float* csp = F.cs + ((size_t)s * 32 + 8 * g) * 2;
        v4u oq1, oq2, ok1, ok2;
#pragma unroll
        for (int j = 0; j < 4; ++j) {
            const f32x4 c4 = *(const f32x4*)(csp + 4 * j);
            const unsigned a = q1[j], bq = q2[j], ka = k1[j], kb = k2[j];
            const float q1l = bf2f((unsigned short)(a & 0xffff)), q1h = bf2f((unsigned short)(a >> 16)), q2l = bf2f((unsigned short)(bq & 0xffff)), q2h = bf2f((unsigned short)(bq >> 16));
            const float k1l = bf2f((unsigned short)(ka & 0xffff)), k1h = bf2f((unsigned short)(ka >> 16)), k2l = bf2f((unsigned short)(kb & 0xffff)), k2h = bf2f((unsigned short)(kb >> 16));
            oq1[j] = pk2(q1l * c4[0] - q2l * c4[1], q1h * c4[2] - q2h * c4[3]); oq2[j] = pk2(q2l * c4[0] + q1l * c4[1], q2h * c4[2] + q1h * c4[3]);
            ok1[j] = pk2((k1l * c4[0] - k2l * c4[1]) * 0.125f, (k1h * c4[2] - k2h * c4[3]) * 0.125f); ok2[j] = pk2((k2l * c4[0] + k1l * c4[1]) * 0.125f, (k2h * c4[2] + k1h * c4[3]) * 0.125f);
        }
        bf16* dq = F.qrb + (size_t)t * 512 + h * 64 + 8 * g; bf16* dk = F.krb + (size_t)t * 512 + h * 64 + 8 * g;
        *(v4u*)dq = oq1; *(v4u*)(dq + 32) = oq2; *(v4u*)dk = ok1; *(v4u*)(dk + 32) = ok2;
    }
}
__device__ __forceinline__ void ret_stage_v(Frame& F, LAS unsigned char* Vt, size_t tok0, int h, int pl) {
    const bf16* vp = F.projb + (tok0 + (pl >> 4)) * IN_WIDTH + 4096 + h * 128 + (pl & 15) * 8;
    v4u vr[8];
#pragma unroll
    for (int i = 0; i < 8; ++i) vr[i] = *(const v4u*)(vp + (size_t)i * 8 * IN_WIDTH);
#pragma unroll
    for (int i = 0; i < 8; ++i) *(LAS v4u*)(Vt + (i * 8 + (pl >> 4)) * 320 + (pl & 15) * 16) = vr[i];
}
__device__ __forceinline__ bf16x8 tr_pair(const LAS unsigned char* p, int rowbytes4) {
    const s16x4 t0 = __builtin_amdgcn_ds_read_tr16_b64_v4i16((LAS s16x4*)p);
    const s16x4 t1 = __builtin_amdgcn_ds_read_tr16_b64_v4i16((LAS s16x4*)(p + rowbytes4));
    bf16x8 v; v[0] = t0[0]; v[1] = t0[1]; v[2] = t0[2]; v[3] = t0[3]; v[4] = t1[0]; v[5] = t1[1]; v[6] = t1[2]; v[7] = t1[3]; return v;
}
__device__ __forceinline__ void ph_ret_a(Frame& F) {
    const int l = lane_id(), w = F.wave, hh = l >> 5, r = l & 31, cpair = w >> 1, vh = w & 1, pl = vh * 64 + l;
    LAS unsigned char* Vt = F.lds + cpair * 32768; LAS unsigned char* Kt = Vt + 20480;
    for (int g = blockIdx.x; g < 256; g += gridDim.x) {
        const int bh = g >> 4, b = bh >> 3, h = bh & 7, c = (g & 15) * 4 + cpair;
        const size_t tok0 = (size_t)b * SEQ + c * 64;
        const float lg2 = lg2_gamma(h);
        __syncthreads();
        ret_stage_v(F, Vt, tok0, h, pl);
        {
            const bf16* kp = F.krb + (tok0 + (pl >> 3)) * 512 + h * 64 + (pl & 7) * 8;
#pragma unroll
            for (int i = 0; i < 4; ++i) {
                const int row = i * 16 + (pl >> 3);
                const v4u kv = *(const v4u*)(kp + (size_t)i * 16 * 512);
                const float z = __builtin_amdgcn_exp2f(lg2 * (float)(63 - row));
                v4u o;
#pragma unroll
                for (int j = 0; j < 4; ++j) o[j] = pk2(bf2f((unsigned short)(kv[j] & 0xffff)) * z, bf2f((unsigned short)(kv[j] >> 16)) * z);
                *(LAS v4u*)(Kt + row * 192 + (pl & 7) * 16) = o;
            }
        }
        __syncthreads();
        f32x16 acc[2][2];
#pragma unroll
        for (int a = 0; a < 2; ++a)
#pragma unroll
            for (int bq = 0; bq < 2; ++bq)
#pragma unroll
                for (int q = 0; q < 16; ++q) acc[a][bq][q] = 0.f;
        const int q4 = (l & 15) >> 2, p4 = l & 3, ch = (l >> 4) & 1;
#pragma unroll
        for (int s = 0; s < 4; ++s) {
            bf16x8 vf[2], kf[2];
#pragma unroll
            for (int a = 0; a < 2; ++a) vf[a] = tr_pair(Vt + (16 * s + 8 * hh + q4) * 320 + ((2 * vh + a) * 32 + ch * 16 + 4 * p4) * 2, 4 * 320);
#pragma unroll
            for (int bq = 0; bq < 2; ++bq) kf[bq] = tr_pair(Kt + (16 * s + 8 * hh + q4) * 192 + (bq * 32 + ch * 16 + 4 * p4) * 2, 4 * 192);
#pragma unroll
            for (int a = 0; a < 2; ++a)
#pragma unroll
                for (int bq = 0; bq < 2; ++bq) acc[a][bq] = MFMA32(vf[a], kf[bq], acc[a][bq]);
        }
        float* ut = F.UT + ((size_t)bh * 64 + c) * 8192;
#pragma unroll
        for (int a = 0; a < 2; ++a)
#pragma unroll
            for (int bq = 0; bq < 2; ++bq)
#pragma unroll
                for (int q = 0; q < 16; ++q) {
                    const int v = (2 * vh + a) * 32 + (q & 3) + 8 * (q >> 2) + 4 * hh;
                    ut[v * 64 + bq * 32 + r] = acc[a][bq][q];
                }
    }
    __syncthreads();
}
__device__ __forceinline__ void ph_ret_scan2(Frame& F) {
    const int gt = (int)blockIdx.x * 512 + (F.wave * 64 + lane_id()), GT = (int)gridDim.x * 512;
    for (int i = gt; i < 2 * 8 * 8192; i += GT) {
        const int e = i & 8191, bh = i >> 13, h = bh & 7;
        const float g = __builtin_amdgcn_exp2f(lg2_gamma(h) * 64.0f);
        float st = 0.f;
        const float* up = F.UT + (size_t)bh * 64 * 8192 + e; bf16* rp = F.RT + (size_t)bh * 64 * 8192 + e;
#pragma unroll 8
        for (int c = 0; c < 64; ++c) { rp[(size_t)c * 8192] = (bf16)f2bf(st); st = g * st + up[(size_t)c * 8192]; }
    }
}
__device__ __forceinline__ void ph_ret_b(Frame& F) {
    const int l = lane_id(), w = F.wave, hh = l >> 5, r = l & 31, cpair = w >> 1, nh = w & 1, pl = nh * 64 + l;
    LAS unsigned char* Vt = F.lds + cpair * 20480;
    for (int g = blockIdx.x; g < 256; g += gridDim.x) {
        const int bh = g >> 4, b = bh >> 3, h = bh & 7, c = (g & 15) * 4 + cpair;
        const size_t tok0 = (size_t)b * SEQ + c * 64;
        const float lg2 = lg2_gamma(h);
        __syncthreads();
        ret_stage_v(F, Vt, tok0, h, pl);
        const int n = nh * 32 + r;
        bf16x8 qf[4], kf[2][4];
        const bf16* qp = F.qrb + (tok0 + n) * 512 + h * 64 + 8 * hh;
#pragma unroll
        for (int s = 0; s < 4; ++s) qf[s] = *(const bf16x8*)(qp + 16 * s);
#pragma unroll
        for (int mb = 0; mb < 2; ++mb) { const bf16* kp = F.krb + (tok0 + mb * 32 + r) * 512 + h * 64 + 8 * hh;
#pragma unroll
            for (int s = 0; s < 4; ++s) kf[mb][s] = *(const bf16x8*)(kp + 16 * s); }
        f32x16 sacc[2];
#pragma unroll
        for (int mb = 0; mb < 2; ++mb) {
#pragma unroll
            for (int q = 0; q < 16; ++q) sacc[mb][q] = 0.f;
#pragma unroll
            for (int s = 0; s < 4; ++s) sacc[mb] = MFMA32(kf[mb][s], qf[s], sacc[mb]);
        }
        bf16x8 pf[2][2];
#pragma unroll
        for (int mb = 0; mb < 2; ++mb) {
            float p[16];
#pragma unroll
            for (int q = 0; q < 16; ++q) { const int m = mb * 32 + (q & 3) + 8 * (q >> 2) + 4 * hh; const int dd = n > m ? n - m : m - n; p[q] = sacc[mb][q] * __builtin_amdgcn_exp2f(lg2 * (float)dd); }
#pragma unroll
            for (int s2 = 0; s2 < 2; ++s2) { v4u pk; pk.x = pg8::cvt_pk_bf16(p[8 * s2], p[8 * s2 + 1]); pk.y = pg8::cvt_pk_bf16(p[8 * s2 + 2], p[8 * s2 + 3]); pk.z = pg8::cvt_pk_bf16(p[8 * s2 + 4], p[8 * s2 + 5]); pk.w = pg8::cvt_pk_bf16(p[8 * s2 + 6], p[8 * s2 + 7]); pf[mb][s2] = __builtin_bit_cast(bf16x8, pk); }
        }
        const float xi = __builtin_amdgcn_exp2f(lg2 * (float)(n + 1));
        bf16x8 qx[4];
#pragma unroll
        for (int s = 0; s < 4; ++s) { const v4u qv = __builtin_bit_cast(v4u, qf[s]); v4u o;
#pragma unroll
            for (int j = 0; j < 4; ++j) o[j] = pk2(bf2f((unsigned short)(qv[j] & 0xffff)) * xi, bf2f((unsigned short)(qv[j] >> 16)) * xi);
            qx[s] = __builtin_bit_cast(bf16x8, o); }
        f32x16 o[4];
#pragma unroll
        for (int vb = 0; vb < 4; ++vb)
#pragma unroll
            for (int q = 0; q < 16; ++q) o[vb][q] = 0.f;
        const bf16* rt = F.RT + ((size_t)bh * 64 + c) * 8192 + 8 * hh;
#pragma unroll
        for (int vb = 0; vb < 4; ++vb) {
            bf16x8 rf[4];
#pragma unroll
            for (int s = 0; s < 4; ++s) rf[s] = *(const bf16x8*)(rt + (size_t)(vb * 32 + r) * 64 + 16 * s);
#pragma unroll
            for (int s = 0; s < 4; ++s) o[vb] = MFMA32(rf[s], qx[s], o[vb]);
        }
        __syncthreads();
        const LAS unsigned char* vt = Vt + (4 * hh + ((l & 15) >> 2)) * 320 + (((l >> 4) & 1) * 16 + 4 * (l & 3)) * 2;
#pragma unroll
        for (int mb = 0; mb < 2; ++mb)
#pragma unroll
            for (int s2 = 0; s2 < 2; ++s2)
#pragma unroll
                for (int vb = 0; vb < 4; ++vb) {
                    const bf16x8 vf = tr_pair(vt + (mb * 32 + 16 * s2) * 320 + vb * 64, 8 * 320);
                    o[vb] = MFMA32(vf, pf[mb][s2], o[vb]);
                }
        float s1 = 0.f;
#pragma unroll
        for (int vb = 0; vb < 4; ++vb)
#pragma unroll
            for (int q = 0; q < 16; ++q) s1 += o[vb][q];
        s1 += __shfl_xor(s1, 32);
        const float mu = s1 * (1.0f / 128.0f); float s2v = 0.f;
#pragma unroll
        for (int vb = 0; vb < 4; ++vb)
#pragma unroll
            for (int q = 0; q < 16; ++q) { const float d = o[vb][q] - mu; s2v += d * d; }
        s2v += __shfl_xor(s2v, 32);
        const float rs = rsqrtf(s2v * (1.0f / 128.0f) + EPS_F);
        const size_t tok = tok0 + n;
#pragma unroll
        for (int vb = 0; vb < 4; ++vb)
#pragma unroll
            for (int gq = 0; gq < 4; ++gq) {
                const int col = h * 128 + vb * 32 + 8 * gq + 4 * hh;
                const uint2 gbv = *(const uint2*)(F.projb + tok * IN_WIDTH + 5120 + col);
                const f32x4 gn = *(const f32x4*)(F.ret_gain + col);
                const float g0 = bf2f((unsigned short)(gbv.x & 0xffff)), g1 = bf2f((unsigned short)(gbv.x >> 16)), g2 = bf2f((unsigned short)(gbv.y & 0xffff)), g3 = bf2f((unsigned short)(gbv.y >> 16));
                uint2 ov;
                ov.x = pg8::cvt_pk_bf16(silu_f(g0) * (o[vb][4 * gq] - mu) * rs * gn[0], silu_f(g1) * (o[vb][4 * gq + 1] - mu) * rs * gn[1]);
                ov.y = pg8::cvt_pk_bf16(silu_f(g2) * (o[vb][4 * gq + 2] - mu) * rs * gn[2], silu_f(g3) * (o[vb][4 * gq + 3] - mu) * rs * gn[3]);
                *(uint2*)(F.ycatb + tok * D_MODEL + 1024 + col) = ov;
            }
    }
    __syncthreads();
}

__device__ __forceinline__ void ph_route2(Frame& F) {
    const int l = lane_id(), gw = (int)blockIdx.x * 8 + F.wave, GW = (int)gridDim.x * 8;
    const f32x4 rb = *(const f32x4*)(F.router_bias + 4 * l);
    for (int t = gw; t < NTOK; t += GW) {
        const f32x4 lg = *(const f32x4*)(F.rsg + (size_t)t * 768 + 4 * l);
        float s[4], bsc[4];
#pragma unroll
        for (int i = 0; i < 4; ++i) { s[i] = sigmoid_f(lg[i]); bsc[i] = s[i] + rb[i]; }
        float m1 = fmaxf(bsc[0], bsc[1]), m2 = fminf(bsc[0], bsc[1]);
        { const float a1 = fmaxf(bsc[2], bsc[3]), a2 = fminf(bsc[2], bsc[3]); const float n1 = fmaxf(m1, a1), n2 = fmaxf(fminf(m1, a1), fmaxf(m2, a2)); m1 = n1; m2 = n2; }
#pragma unroll
        for (int o = 1; o < 8; o <<= 1) { const float a1 = __shfl_xor(m1, o), a2 = __shfl_xor(m2, o); const float n1 = fmaxf(m1, a1), n2 = fmaxf(fminf(m1, a1), fmaxf(m2, a2)); m1 = n1; m2 = n2; }
        const float gs = m1 + m2; const int grp = l >> 3;
        int rank = 0;
#pragma unroll
        for (int g = 0; g < 8; ++g) { const float og = __shfl(gs, 8 * g); rank += (og > gs || (og == gs && g < grp)) ? 1 : 0; }
        const bool sel = rank < 4;
        float mv[4];
#pragma unroll
        for (int i = 0; i < 4; ++i) mv[i] = sel ? bsc[i] : -1e30f;
        float wsum = 0.f; int myidx = 0; float mysc = 0.f;
#pragma unroll
        for (int rr = 0; rr < 8; ++rr) {
            float bv = mv[0]; int bi = 4 * l; float bs = s[0];
#pragma unroll
            for (int i = 1; i < 4; ++i) if (mv[i] > bv) { bv = mv[i]; bi = 4 * l + i; bs = s[i]; }
#pragma unroll
            for (int o = 1; o < 64; o <<= 1) {
                const float ov = __shfl_xor(bv, o); const int oi = __shfl_xor(bi, o); const float os = __shfl_xor(bs, o);
                if (ov > bv || (ov == bv && oi < bi)) { bv = ov; bi = oi; bs = os; }
            }
            wsum += bs;
            if (l == rr) { myidx = bi; mysc = bs; }
#pragma unroll
            for (int i = 0; i < 4; ++i) if (bi == 4 * l + i) mv[i] = -3e30f;
        }
        if (l < 8) {
            const int slot = atomicAdd(&F.counts[myidx], 1);
            F.lists[myidx * NTOK + slot] = t * 8 + l; F.a_w[t * 8 + l] = mysc / wsum * 2.5f;
        }
    }
}
__device__ __forceinline__ void ph_swiglu2(Frame& F) {
    const size_t gt = (size_t)blockIdx.x * 512 + (F.wave * 64 + lane_id()), GT = (size_t)gridDim.x * 512;
    for (size_t i = gt; i < (size_t)NTOK * 64; i += GT) { const size_t t = i >> 6; const int j = (int)(i & 63) * 4;
        const f32x4 ga = *(const f32x4*)(F.rsg + t * 768 + 256 + j), up = *(const f32x4*)(F.rsg + t * 768 + 512 + j);
        uint2 o; o.x = pk2(silu_f(ga[0]) * up[0], silu_f(ga[1]) * up[1]); o.y = pk2(silu_f(ga[2]) * up[2], silu_f(ga[3]) * up[3]);
        *(uint2*)(F.sactb + t * 256 + j) = o; }
}
template <bool XRES_BF16, bool HAS_CONTRIB>
__device__ __forceinline__ void ph_res_ln2(Frame& F, const void* __restrict__ xres_, const float* __restrict__ y, const bf16* __restrict__ contrib, int g_off,
                                           const float* __restrict__ gain, const float* __restrict__ bias, float* __restrict__ xo_f32, bf16* __restrict__ xo_bf16, int sh_off, int sc_off, bf16* __restrict__ hmod) {
    const int gw = (int)blockIdx.x * 8 + F.wave, GW = (int)gridDim.x * 8;
    for (int t = gw; t < NTOK; t += GW) {
        const unsigned lo = 8u * (unsigned)lane_id();
        const int b = t / SEQ; const float* mb = F.mod + b * 6 * D_MODEL;
        const float* yrow = y + (size_t)t * D_MODEL;
        const bf16* crow = contrib + (size_t)t * 8 * D_MODEL;
        const bf16* xrb = (const bf16*)xres_ + (size_t)t * D_MODEL; const float* xrf = (const float*)xres_ + (size_t)t * D_MODEL;
        float z[32]; float s = 0.f;
#pragma unroll
        for (int j = 0; j < 4; ++j) {
            const unsigned d = lo + 512u * j;
            asm volatile("" ::: "memory");
            float yy[8];
            { const f32x4 a = *(const f32x4*)(yrow + d), c = *(const f32x4*)(yrow + d + 4); yy[0] = a[0]; yy[1] = a[1]; yy[2] = a[2]; yy[3] = a[3]; yy[4] = c[0]; yy[5] = c[1]; yy[6] = c[2]; yy[7] = c[3]; }
            if (HAS_CONTRIB) {
#pragma unroll
                for (int k = 0; k < 8; ++k) { const v4u cv = *(const v4u*)(crow + (unsigned)(k * D_MODEL) + d);
#pragma unroll
                    for (int q = 0; q < 4; ++q) { yy[2 * q] += bf2f((unsigned short)(cv[q] & 0xffff)); yy[2 * q + 1] += bf2f((unsigned short)(cv[q] >> 16)); } }
            }
            float xr[8];
            if (XRES_BF16) { const v4u xv = *(const v4u*)(xrb + d);
#pragma unroll
                for (int q = 0; q < 4; ++q) { xr[2 * q] = bf2f((unsigned short)(xv[q] & 0xffff)); xr[2 * q + 1] = bf2f((unsigned short)(xv[q] >> 16)); } }
            else { const f32x4 a = *(const f32x4*)(xrf + d), c = *(const f32x4*)(xrf + d + 4); xr[0] = a[0]; xr[1] = a[1]; xr[2] = a[2]; xr[3] = a[3]; xr[4] = c[0]; xr[5] = c[1]; xr[6] = c[2]; xr[7] = c[3]; }
            const f32x4 g0 = *(const f32x4*)(mb + g_off + d), g1 = *(const f32x4*)(mb + g_off + d + 4);
#pragma unroll
            for (int q = 0; q < 8; ++q) { const float gg = q < 4 ? g0[q & 3] : g1[q & 3]; z[8 * j + q] = ALPHA_F * xr[q] + gg * yy[q]; s += z[8 * j + q]; }
        }
        s = wave_sum(s);
        const float mu = s * (1.0f / D_MODEL); float qv = 0.f;
#pragma unroll
        for (int j = 0; j < 32; ++j) { const float dv = z[j] - mu; qv += dv * dv; }
        qv = wave_sum(qv);
        const float rs = rsqrtf(qv * (1.0f / D_MODEL) + EPS_F);
        float* of = xo_f32 + (size_t)t * D_MODEL; bf16* ob = xo_bf16 + (size_t)t * D_MODEL; bf16* oh = hmod + (size_t)t * D_MODEL;
        const unsigned lo2 = 8u * (unsigned)lane_id();
#pragma unroll
        for (int j = 0; j < 4; ++j) {
            const unsigned d = lo2 + 512u * j;
            asm volatile("" ::: "memory");
            const f32x4 ga = *(const f32x4*)(gain + d), gb = *(const f32x4*)(gain + d + 4), ba = *(const f32x4*)(bias + d), bb = *(const f32x4*)(bias + d + 4);
            float v[8];
#pragma unroll
            for (int q = 0; q < 8; ++q) v[q] = (z[8 * j + q] - mu) * rs * (q < 4 ? ga[q & 3] : gb[q & 3]) + (q < 4 ? ba[q & 3] : bb[q & 3]);
            if (xo_f32) { *(f32x4*)(of + d) = (f32x4){v[0], v[1], v[2], v[3]}; *(f32x4*)(of + d + 4) = (f32x4){v[4], v[5], v[6], v[7]}; }
            if (xo_bf16) { v4u w; w.x = pk2(v[0], v[1]); w.y = pk2(v[2], v[3]); w.z = pk2(v[4], v[5]); w.w = pk2(v[6], v[7]); *(v4u*)(ob + d) = w; }
            if (hmod) {
                const f32x4 c0 = *(const f32x4*)(mb + sc_off + d), c1 = *(const f32x4*)(mb + sc_off + d + 4), h0 = *(const f32x4*)(mb + sh_off + d), h1 = *(const f32x4*)(mb + sh_off + d + 4);
                float hv[8];
#pragma unroll
                for (int q = 0; q < 8; ++q) hv[q] = v[q] * (1.0f + (q < 4 ? c0[q & 3] : c1[q & 3])) + (q < 4 ? h0[q & 3] : h1[q & 3]);
                v4u w; w.x = pk2(hv[0], hv[1]); w.y = pk2(hv[2], hv[3]); w.z = pk2(hv[4], hv[5]); w.w = pk2(hv[6], hv[7]); *(v4u*)(oh + d) = w;
            }
        }
    }
}

struct Args { const float* in[21]; float* out; unsigned char* ws; int ph_lo, ph_hi, li, pad; };
constexpr size_t WS_CTL_BYTES = 65536;

__global__ void __launch_bounds__(512, 2) mk_fwd(Args a) {
    extern __shared__ __attribute__((aligned(16))) unsigned char lds_raw[];
    Frame F;
    F.lds = (LAS unsigned char*)lds_raw;
    F.nvb = gridDim.x * 2;
    F.wave = __builtin_amdgcn_readfirstlane((int)threadIdx.x >> 6); F.G = gridDim.x;
    { const int bx = blockIdx.x; F.vcu = (F.G % 8 == 0) ? (bx % 8) * (F.G / 8) + bx / 8 : bx; }
    F.ctl = (unsigned*)a.ws;
    F.x = a.in[0]; F.c = a.in[1]; F.w_ada = a.in[2]; F.b_ada = a.in[3]; F.w_in = a.in[4]; F.rel_bias = a.in[5]; F.attn_gain = a.in[6]; F.ret_gain = a.in[7]; F.w_out = a.in[8];
    F.ln1_g = a.in[9]; F.ln1_b = a.in[10]; F.w_router = a.in[11]; F.router_bias = a.in[12]; F.w_gate = a.in[13]; F.w_up = a.in[14]; F.w_down = a.in[15]; F.ws_gate = a.in[16];
    F.ws_up = a.in[17]; F.ws_down = a.in[18]; F.ln2_g = a.in[19]; F.ln2_b = a.in[20]; F.out = a.out;
    {
        unsigned char* w = a.ws; size_t off = WS_CTL_BYTES;
#define CARVE(T, name, bytes) name = (T*)(w + off); off += (((size_t)(bytes)) + 255) & ~(size_t)255
        F.counts = (int*)(w + 61440);
        CARVE(float, F.mod, 2 * 6 * D_MODEL * 4); CARVE(float, F.cs, SEQ * 32 * 2 * 4); CARVE(float, F.h1, (size_t)NTOK * D_MODEL * 4); CARVE(float, F.proj, (size_t)NTOK * IN_WIDTH * 4);
        CARVE(float, F.qr, (size_t)NTOK * 512 * 4); CARVE(float, F.kr, (size_t)NTOK * 512 * 4); CARVE(float, F.attn_out, (size_t)NTOK * 1024 * 4);
        CARVE(float, F.U, (size_t)2 * 8 * 64 * 8192 * 4); CARVE(float, F.R, (size_t)2 * 8 * 64 * 8192 * 4); CARVE(float, F.ycat, (size_t)NTOK * D_MODEL * 4);
        CARVE(float, F.mixer, (size_t)NTOK * D_MODEL * 4); CARVE(float, F.x1, (size_t)NTOK * D_MODEL * 4); CARVE(float, F.h2, (size_t)NTOK * D_MODEL * 4);
        CARVE(float, F.logits, (size_t)NTOK * NEXP * 4); CARVE(int, F.lists, (size_t)NEXP * NTOK * 4); CARVE(int, F.a_exp, (size_t)NTOK * 8 * 4); CARVE(float, F.a_w, (size_t)NTOK * 8 * 4);
        CARVE(float, F.act, (size_t)NTOK * 8 * EDIM * 4); CARVE(float, F.contrib, (size_t)NTOK * 8 * D_MODEL * 4); CARVE(float, F.sgu, (size_t)NTOK * 512 * 4);
        CARVE(float, F.sact, (size_t)NTOK * 256 * 4); CARVE(float, F.sh_out, (size_t)NTOK * D_MODEL * 4);
        CARVE(float, F.modp, (size_t)16 * 2 * 6 * D_MODEL * 4); CARVE(bf16, F.w_in_t, (size_t)IN_WIDTH * D_MODEL * 2); CARVE(bf16, F.h1b, (size_t)NTOK * D_MODEL * 2);
        CARVE(bf16, F.w_out_t, (size_t)D_MODEL * D_MODEL * 2); CARVE(bf16, F.wr_t, (size_t)768 * D_MODEL * 2); CARVE(bf16, F.ws_down_t, (size_t)D_MODEL * 256 * 2);
        CARVE(bf16, F.ycatb, (size_t)NTOK * D_MODEL * 2); CARVE(bf16, F.h2b, (size_t)NTOK * D_MODEL * 2); CARVE(bf16, F.sactb, (size_t)NTOK * 256 * 2); CARVE(float, F.rsg, (size_t)NTOK * 768 * 4);
        CARVE(bf16, F.actb, (size_t)(NTOK * 8 + 512) * EDIM * 2); CARVE(bf16, F.contribb, (size_t)NTOK * 8 * D_MODEL * 2);
        CARVE(bf16, F.projb, (size_t)NTOK * IN_WIDTH * 2); CARVE(float, F.ssq, (size_t)NTOK * 8 * 4);
        CARVE(bf16, F.qrb, (size_t)NTOK * 512 * 2); CARVE(bf16, F.krb, (size_t)NTOK * 512 * 2); CARVE(float, F.UT, (size_t)16 * 64 * 8192 * 4); CARVE(bf16, F.RT, (size_t)16 * 64 * 8192 * 2); CARVE(bf16, F.x1b, (size_t)NTOK * D_MODEL * 2);
#undef CARVE
    }
    for (int u = (F.wave * 64 + lane_id()); u < (LDS_BYTES - 131072) / 4; u += 512) ((LAS unsigned*)(F.lds + 131072))[u] = 0u;
    __syncthreads();
    volatile LAS unsigned* MISC = (volatile LAS unsigned*)(F.lds + MISC_OFF);
    XcdBarrier bar = xcd_barrier_post((unsigned*)a.ws + a.li * 4096, MISC + 8, F.wave);
    const int lo = a.ph_lo, hi = a.ph_hi;
#define IN(k) (lo <= (k) && (k) < hi)
#define SEAM(k) do { if (IN(k) && IN((k) + 1)) xcd_barrier(bar); } while (0)
    if (IN(0)) { p0_prologue(F); } SEAM(0);
    if (IN(1)) { p1_modulate_bf16(F); } SEAM(1);
    if (IN(2)) {
        pg8::Gemm g{F.h1b, F.w_in_t, NTOK, IN_WIDTH, D_MODEL}; pg8::StaticOrder S; S.init(NTOK, IN_WIDTH, F.G, (int)blockIdx.x);
        pg8::EpiBf16P E{F.projb, IN_WIDTH, 0};
        pg8::gemm_phase<pg8::EpiBf16P, pg8::StaticOrder, true, true>(F.lds, g, S, E, F.wave);
    } SEAM(2);
    if (IN(3)) { ph_attn(F); ph_rot2(F); } SEAM(3);
    if (IN(4)) { ph_ret_a(F); } SEAM(4);
    if (IN(5)) { ph_ret_scan2(F); } SEAM(5);
    if (IN(6)) { ph_ret_b(F); } SEAM(6);
    if (IN(7)) {
        pg8::Gemm g{F.ycatb, F.w_out_t, NTOK, D_MODEL, D_MODEL}; pg8::StaticOrder S; S.init(NTOK, D_MODEL, F.G, (int)blockIdx.x);
        pg8::EpiF32Mid E{F.mixer, D_MODEL, 16, F.ssq};
        pg8::gemm_phase<pg8::EpiF32Mid, pg8::StaticOrder, true, true>(F.lds, g, S, E, F.wave);
    } SEAM(7);
    if (IN(8)) { ph_res_ln2<false, false>(F, F.x, F.mixer, nullptr, 2 * D_MODEL, F.ln1_g, F.ln1_b, nullptr, F.x1b, 3 * D_MODEL, 4 * D_MODEL, F.h2b); } SEAM(8);
    if (IN(9)) {
        pg8::Gemm g{F.h2b, F.wr_t, NTOK, 768, D_MODEL}; pg8::StaticOrder S; S.init(NTOK, 768, F.G, (int)blockIdx.x);
        pg8::EpiF32 E{F.rsg, 768, 0};
        pg8::gemm_phase<pg8::EpiF32, pg8::StaticOrder, true, true>(F.lds, g, S, E, F.wave);
    } SEAM(9);
    if (IN(10)) { ph_route2(F); ph_swiglu2(F); } SEAM(10);
    if (IN(11)) { moe_stage<0>(F);
        pg8::Gemm g{F.sactb, F.ws_down_t, NTOK, D_MODEL, 256}; pg8::StaticOrder S; S.init(NTOK, D_MODEL, F.G, (int)blockIdx.x);
        pg8::EpiF32 E{F.sh_out, D_MODEL, 0};
        pg8::gemm_phase<pg8::EpiF32, pg8::StaticOrder, true, true>(F.lds, g, S, E, F.wave);
    } SEAM(11);
    if (IN(12)) { moe_stage<1>(F); } SEAM(12);
    if (IN(13)) { ph_res_ln2<true, true>(F, F.x1b, F.sh_out, F.contribb, 5 * D_MODEL, F.ln2_g, F.ln2_b, F.out, nullptr, 0, 0, nullptr); }
#undef IN
#undef SEAM
}

extern "C" void kernel_launch(void* const* d_in, const int* in_sizes, int n_in, void* d_out, int out_size, void* d_ws, size_t ws_size, hipStream_t stream) {
    static int grid = 0;
    if (grid == 0) {
        int dev = 0, cus = 0, per_cu = 0;
        if (hipGetDevice(&dev) != hipSuccess || hipDeviceGetAttribute(&cus, hipDeviceAttributeMultiprocessorCount, dev) != hipSuccess) { fprintf(stderr, "kernel_launch: device query failed\n"); grid = -1; return; }
        if (hipFuncSetAttribute((const void*)mk_fwd, hipFuncAttributeMaxDynamicSharedMemorySize, LDS_BYTES) != hipSuccess) { fprintf(stderr, "kernel_launch: hipFuncSetAttribute failed\n"); grid = -1; return; }
        if (hipOccupancyMaxActiveBlocksPerMultiprocessor(&per_cu, (const void*)mk_fwd, 512, LDS_BYTES) != hipSuccess || per_cu < 1)
            fprintf(stderr, "kernel_launch: occupancy query reports %d workgroups per CU\n", per_cu);
        (void)hipGetLastError();
        grid = cus;
    }
    if (grid < 0) return;
    if (hipMemsetAsync(d_ws, 0, WS_CTL_BYTES, stream) != hipSuccess) { fprintf(stderr, "kernel_launch: memset failed\n"); return; }
    Args a{};
    for (int i = 0; i < 21; ++i) a.in[i] = (const float*)d_in[i];
    a.out = (float*)d_out; a.ws = (unsigned char*)d_ws;
    for (int li = 0; li < MK_N_LAUNCHES; ++li) {
        a.ph_lo = li * N_PHASES / MK_N_LAUNCHES; a.ph_hi = (li + 1) * N_PHASES / MK_N_LAUNCHES; a.li = li;
        hipLaunchKernelGGL(mk_fwd, dim3(grid), dim3(512), LDS_BYTES, stream, a);
        const hipError_t le = hipPeekAtLastError();
        if (le != hipSuccess) { fprintf(stderr, "kernel_launch: launch %d failed: %s\n", li, hipGetErrorName(le)); break; }
    }
}
```

```cpp
#include <hip/hip_runtime.h>
#include <cstdint>
#include <cstdio>

#define D_MODEL 2048
#define SEQ 4096
#define NTOK 8192
#define IN_WIDTH 6144
#define NEXP 256
#define EDIM 256
#define ALPHA_F 1.189207115002721f
#define EPS_F 1e-5f
#define LAS __attribute__((address_space(3)))

#ifndef MK_N_LAUNCHES
#define MK_N_LAUNCHES 1
#endif
constexpr int N_PHASES = 14;
constexpr int LDS_BYTES = 147456;
constexpr int MISC_OFF = 131072 + 320;

__device__ __forceinline__ int lane_id() { int v; asm volatile("v_mbcnt_lo_u32_b32 %0, -1, 0\n\tv_mbcnt_hi_u32_b32 %0, -1, %0" : "=v"(v)); return v; }
#define XB_TMO      128
#define XB_XCNT(j)  (256  + 64 * (j))
#define XB_XSUB(j)  (1280 + 64 * (j))
#define XB_XGEN(j)  (2304 + 64 * (j))
#define XB_TOP      3328
#define XB_TOPGEN   3392
#define XCD_BAR_WORDS 3456
#define XB_SPIN_CAP (1u << 18)
__device__ __forceinline__ unsigned xb_ld(unsigned* p)              { return __hip_atomic_load(p, __ATOMIC_RELAXED, __HIP_MEMORY_SCOPE_AGENT); }
__device__ __forceinline__ unsigned xb_add(unsigned* p, unsigned v) { return __hip_atomic_fetch_add(p, v, __ATOMIC_RELAXED, __HIP_MEMORY_SCOPE_AGENT); }
__device__ __forceinline__ unsigned xb_xcc_id() { return (unsigned)__builtin_amdgcn_s_getreg((3 << 11) | 20) & 0xFu; }
#define XB_SPIN(cond, bar) do { unsigned _sp = 0; while (cond) { __builtin_amdgcn_s_sleep(1); \
    if ((++_sp & 255u) == 0u) { if (xb_ld(&(bar)[XB_TMO])) break; if (_sp > XB_SPIN_CAP) { atomicAdd(&(bar)[XB_TMO], 1u); break; } } } } while (0)
struct XcdBarrier { unsigned* bar; unsigned x; volatile LAS unsigned* st; int wave; };
__device__ __forceinline__ XcdBarrier xcd_barrier_post(unsigned* bar, volatile LAS unsigned* st, int wave) {
    XcdBarrier b; b.bar = bar; b.x = xb_xcc_id(); b.st = st; b.wave = wave;
    if (wave == 0 && lane_id() == 0) (void)xb_add(&bar[XB_XCNT(b.x)], 1u);
    return b;
}
__device__ __forceinline__ void xcd_barrier_complete(unsigned* bar, unsigned x, unsigned& nloc, unsigned& nx) {
    const unsigned G = gridDim.x * gridDim.y * gridDim.z;
    unsigned sum, cnt, mine, sp = 0u;
    for (;;) {
        sum = 0u; cnt = 0u; mine = 0u;
#pragma unroll
        for (unsigned j = 0; j < 16; ++j) { const unsigned c = xb_ld(&bar[XB_XCNT(j)]); sum += c; cnt += (c > 0u) ? 1u : 0u; mine = (j == x) ? c : mine; }
        if (sum == G) break;
        __builtin_amdgcn_s_sleep(1);
        if ((++sp & 255u) == 0u) { if (xb_ld(&bar[XB_TMO])) break; if (sp > XB_SPIN_CAP) { atomicAdd(&bar[XB_TMO], 1u); break; } }
    }
    nloc = mine > 0u ? mine : 1u; nx = cnt > 0u ? cnt : 1u;
}
__device__ __forceinline__ void xcd_barrier(const XcdBarrier& b) {
    asm volatile("s_waitcnt vmcnt(0)" ::: "memory");
    __syncthreads();
    if (b.wave == 0 && lane_id() == 0) {
        unsigned* bar = b.bar;
        __builtin_amdgcn_s_waitcnt(0);
        unsigned nloc = b.st[0], nx = b.st[1];
        if (nloc == 0u) { xcd_barrier_complete(bar, b.x, nloc, nx); b.st[0] = nloc; b.st[1] = nx; }
        const unsigned old = xb_add(&bar[XB_XSUB(b.x)], 1u);
        const unsigned gen = old / nloc;
        if (old + 1u == (gen + 1u) * nloc) {
            __builtin_amdgcn_fence(__ATOMIC_RELEASE, "agent");
            asm volatile("s_waitcnt vmcnt(0)" ::: "memory");
            const unsigned og = xb_add(&bar[XB_TOP], 1u);
            const unsigned tg = og / nx;
            if (og + 1u == (tg + 1u) * nx) xb_add(&bar[XB_TOPGEN], 1u);
            else XB_SPIN(xb_ld(&bar[XB_TOPGEN]) == tg, bar);
            __builtin_amdgcn_fence(__ATOMIC_ACQUIRE, "agent");
            xb_add(&bar[XB_XGEN(b.x)], 1u);
            asm volatile("s_waitcnt vmcnt(0)" ::: "memory");
        } else {
            XB_SPIN(xb_ld(&bar[XB_XGEN(b.x)]) == gen, bar);
            __builtin_amdgcn_fence(__ATOMIC_ACQUIRE, "agent");
            asm volatile("s_waitcnt vmcnt(0)" ::: "memory");
        }
    }
    __syncthreads();
}

__device__ __forceinline__ float silu_f(float v) { return v / (1.0f + __expf(-v)); }
__device__ __forceinline__ float sigmoid_f(float v) { return 1.0f / (1.0f + __expf(-v)); }
__device__ __forceinline__ float log_gamma(int h) { return logf(1.0f - exp2f(-5.0f - (float)h)); }

namespace pg8 {
#define PG8_LAS __attribute__((address_space(3)))
typedef unsigned short bf16_t;
typedef short bf16x8 __attribute__((ext_vector_type(8)));
typedef float f32x4 __attribute__((ext_vector_type(4)));
typedef unsigned u32x4 __attribute__((ext_vector_type(4)));
constexpr int BM = 256, BK = 64, HALF = 128, HTB = HALF * BK * 2  , STAGE_BYTES = 8 * HTB, NXCD = 8, WGM = 8;

__host__ __device__ __forceinline__ int lds_byte(int r, int c) { const int st = (r >> 4) * 2 + (c >> 5), rr = r & 15, cc = c & 31, ob = rr * 64 + cc * 2; return st * 1024 + (ob ^ (((ob >> 9) & 1) << 5)); }
__host__ __device__ __forceinline__ void stage_rc(int b, int& R, int& C) { const int st = b / 1024, sb = b % 1024, swz = sb ^ (((sb >> 9) & 1) << 5); R = (st >> 1) * 16 + swz / 64; C = (st & 1) * 32 + (swz % 64) / 2; }
__host__ __device__ __forceinline__ int perm32(int rho) { const int n = rho >> 4, i = rho & 15; return 8 * (i >> 2) + 4 * n + (i & 3); }

struct Unit { int pm, pn; };
struct Gemm { const bf16_t* A; const bf16_t* Bt; int M, N, K; };

struct StaticOrder {
    int nM, nN, nwg, G, c;
    __host__ __device__ void init(int M, int N, int G_, int c_) { nM = M / BM; nN = N / BM; nwg = nM * nN; G = G_; c = c_; }
    __host__ __device__ bool next(int i, Unit& u) const {
        const long L = (long)i * G + c; if (L >= nwg) return false;
        int wgid = (int)L; { const int q = nwg / NXCD, r = nwg % NXCD, xcd = wgid % NXCD, off = wgid / NXCD; wgid = (xcd < r ? xcd * (q + 1) : r * (q + 1) + (xcd - r) * q) + off; }
        const int nig = WGM * nN, gid = wgid / nig, fm = gid * WGM, gsz = (nM - fm) < WGM ? (nM - fm) : WGM;
        u.pm = fm + ((wgid % nig) % gsz); u.pn = (wgid % nig) / gsz; return true;
    }
    __device__ __forceinline__ void a_ready(const Unit&) const {}
    __device__ __forceinline__ void done(const Unit&) const {}
};

__device__ __forceinline__ unsigned cvt_pk_bf16(float lo, float hi) { unsigned r; asm volatile("v_cvt_pk_bf16_f32 %0, %1, %2" : "=v"(r) : "v"(lo), "v"(hi)); return r; }
struct EpiF32 {
    static constexpr bool PERM = true, AFTER_DRAIN = false, MIDK = false;
    float* C; int ldc; int midk_tile;
    __device__ __forceinline__ void midscale(f32x4 (&acc)[2][2][4][2], const Unit& u, int wr, int wc, int fr, int fq) const {}
    __device__ __forceinline__ void operator()(const f32x4 (&acc)[2][2][4][2], const Unit& u, int wr, int wc, int fr, int fq) const {
        const int row0 = u.pm * BM + wr * 64 + fr, col0 = u.pn * BM + wc * 32 + 8 * fq;
#pragma unroll
        for (int ai = 0; ai < 2; ++ai)
#pragma unroll
            for (int m = 0; m < 4; ++m) { float* rowp = C + (size_t)(row0 + ai * HALF + m * 16) * ldc + col0;
#pragma unroll
                for (int bj = 0; bj < 2; ++bj) { *(f32x4*)(rowp + bj * HALF) = acc[ai][bj][m][0]; *(f32x4*)(rowp + bj * HALF + 4) = acc[ai][bj][m][1]; } }
    }
};

struct EpiBf16P {
    static constexpr bool PERM = true, AFTER_DRAIN = false, MIDK = false;
    bf16_t* O; int ldc; int midk_tile;
    __device__ __forceinline__ void midscale(f32x4 (&acc)[2][2][4][2], const Unit& u, int wr, int wc, int fr, int fq) const {}
    __device__ __forceinline__ void operator()(const f32x4 (&acc)[2][2][4][2], const Unit& u, int wr, int wc, int fr, int fq) const {
        const int row0 = u.pm * BM + wr * 64 + fr, col0 = u.pn * BM + wc * 32 + 8 * fq;
#pragma unroll
        for (int ai = 0; ai < 2; ++ai)
#pragma unroll
            for (int m = 0; m < 4; ++m) { bf16_t* rowp = O + (size_t)(row0 + ai * HALF + m * 16) * ldc + col0;
#pragma unroll
                for (int bj = 0; bj < 2; ++bj) { const f32x4 v0 = acc[ai][bj][m][0], v1 = acc[ai][bj][m][1];
                    u32x4 w; w.x = cvt_pk_bf16(v0[0], v0[1]); w.y = cvt_pk_bf16(v0[2], v0[3]); w.z = cvt_pk_bf16(v1[0], v1[1]); w.w = cvt_pk_bf16(v1[2], v1[3]);
                    *(u32x4*)(rowp + bj * HALF) = w; } }
    }
};
struct EpiF32Mid {
    static constexpr bool PERM = true, AFTER_DRAIN = false, MIDK = true;
    float* C; int ldc; int midk_tile; const float* ssq;
    __device__ __forceinline__ void midscale(f32x4 (&acc)[2][2][4][2], const Unit& u, int wr, int wc, int fr, int fq) const {
#pragma unroll
        for (int ai = 0; ai < 2; ++ai)
#pragma unroll
            for (int m = 0; m < 4; ++m) {
                const int row = u.pm * BM + ai * HALF + wr * 64 + m * 16 + fr;
                const f32x4 a = *(const f32x4*)(ssq + (size_t)row * 8), b = *(const f32x4*)(ssq + (size_t)row * 8 + 4);
                const float tot = ((a[0] + a[1]) + (a[2] + a[3])) + ((b[0] + b[1]) + (b[2] + b[3]));
                const float rs = rsqrtf(tot * (1.0f / 1024.0f) + 1e-5f);
#pragma unroll
                for (int bj = 0; bj < 2; ++bj)
#pragma unroll
                    for (int n = 0; n < 2; ++n) acc[ai][bj][m][n] *= rs;
            }
    }
    __device__ __forceinline__ void operator()(const f32x4 (&acc)[2][2][4][2], const Unit& u, int wr, int wc, int fr, int fq) const {
        const int row0 = u.pm * BM + wr * 64 + fr, col0 = u.pn * BM + wc * 32 + 8 * fq;
#pragma unroll
        for (int ai = 0; ai < 2; ++ai)
#pragma unroll
            for (int m = 0; m < 4; ++m) { float* rowp = C + (size_t)(row0 + ai * HALF + m * 16) * ldc + col0;
#pragma unroll
                for (int bj = 0; bj < 2; ++bj) { *(f32x4*)(rowp + bj * HALF) = acc[ai][bj][m][0]; *(f32x4*)(rowp + bj * HALF + 4) = acc[ai][bj][m][1]; } }
    }
};
template <class Epi, class Sched, bool ALIGN_EPI = false, bool SP2 = false>
__device__ __forceinline__ void gemm_phase(PG8_LAS unsigned char* lds, const Gemm g, const Sched& S, const Epi& E, const int wid) {
    const int lane = lane_id(), tid = wid * 64 + lane, wr = wid >> 2, wc = wid & 3, fr = lane & 15, fq = lane >> 4;
    const int K = g.K, nt = K / BK;
    unsigned voffA[2], voffB[2];
#pragma unroll
    for (int i = 0; i < 2; ++i) { int R, C; stage_rc(tid * 16 + i * 8192, R, C); const int Rb = Epi::PERM ? ((R & ~31) + perm32(R & 31)) : R;
        voffA[i] = (unsigned)(R * K + C) * 2u; voffB[i] = (unsigned)(Rb * K + C) * 2u; }
    const size_t kstep = (size_t)(BK * 2);
    const size_t hstep = (size_t)HALF * K * 2;
    const size_t tstep = 2 * hstep;
    const unsigned ldsw = (unsigned)wid * 1024u;
    const int aoff = lds_byte(wr * 64 + fr, fq * 8), boff = lds_byte(wc * 32 + fr, fq * 8);
#define PG8_SA(b, h) (((b) * 2 + (h)) * HTB)
#define PG8_SB(b, h) ((4 + (b) * 2 + (h)) * HTB)
#define PG8_STAGE(bufoff, gbase, voff) do { _Pragma("unroll") for (int _i = 0; _i < 2; ++_i) \
        __builtin_amdgcn_global_load_lds((const unsigned*)((const char*)(gbase) + (voff)[_i]), (PG8_LAS unsigned*)(lds + (bufoff) + ldsw + _i * 8192), 16, 0, 0); } while (0)
#define PG8_LDA(dst, b, h) do { _Pragma("unroll") for (int m = 0; m < 4; ++m) _Pragma("unroll") for (int k = 0; k < 2; ++k) dst[m][k] = *(const PG8_LAS bf16x8*)(lds + PG8_SA(b, h) + aoff + m * 2048 + k * 1024); } while (0)
#define PG8_LDB(dst, b, h) do { _Pragma("unroll") for (int n = 0; n < 2; ++n) _Pragma("unroll") for (int k = 0; k < 2; ++k) dst[n][k] = *(const PG8_LAS bf16x8*)(lds + PG8_SB(b, h) + boff + n * 2048 + k * 1024); } while (0)
#define PG8_MMA(ai, bj, At, Bt) do { __builtin_amdgcn_s_setprio(1); _Pragma("unroll") for (int m = 0; m < 4; ++m) _Pragma("unroll") for (int n = 0; n < 2; ++n) _Pragma("unroll") for (int k = 0; k < 2; ++k) \
        acc[ai][bj][m][n] = __builtin_amdgcn_mfma_f32_16x16x32_bf16(Bt[n][k], At[m][k], acc[ai][bj][m][n], 0, 0, 0); __builtin_amdgcn_s_setprio(0); } while (0)
#define PG8_WAIT_V(n) asm volatile("s_waitcnt vmcnt(" #n ")" ::: "memory")
#define PG8_WAIT_L(n) asm volatile("s_waitcnt lgkmcnt(" #n ")" ::: "memory")
#define PG8_BAR __builtin_amdgcn_s_barrier()
#define PG8_SCHED __builtin_amdgcn_sched_barrier(0)
    Unit cur, nxt; int ui = 0;
    if (!S.next(0, cur)) return;
    f32x4 acc[2][2][4][2];
#pragma unroll
    for (int a = 0; a < 2; ++a)
#pragma unroll
        for (int b = 0; b < 2; ++b)
#pragma unroll
            for (int m = 0; m < 4; ++m)
#pragma unroll
                for (int n = 0; n < 2; ++n) acc[a][b][m][n] = (f32x4){0.f, 0.f, 0.f, 0.f};
    bf16x8 At[4][2], B0[2][2], B1[2][2];
    const char* cA = (const char*)g.A + (size_t)cur.pm * tstep; const char* cB = (const char*)g.Bt + (size_t)cur.pn * tstep;
    S.a_ready(cur);
    if constexpr (SP2) {
        PG8_STAGE(PG8_SB(0, 0), cB, voffB); PG8_STAGE(PG8_SB(0, 1), cB + hstep, voffB); PG8_STAGE(PG8_SA(0, 0), cA, voffA); PG8_STAGE(PG8_SA(0, 1), cA + hstep, voffA);
        if (wr == 1) PG8_BAR;
        PG8_WAIT_V(2); PG8_BAR;
        PG8_STAGE(PG8_SB(1, 0), cB + kstep, voffB); PG8_STAGE(PG8_SA(1, 0), cA + kstep, voffA); PG8_STAGE(PG8_SB(1, 1), cB + hstep + kstep, voffB);
        PG8_WAIT_V(6); PG8_BAR;
    } else {
        PG8_STAGE(PG8_SB(0, 0), cB, voffB); PG8_STAGE(PG8_SA(0, 0), cA, voffA); PG8_STAGE(PG8_SB(0, 1), cB + hstep, voffB); PG8_STAGE(PG8_SA(0, 1), cA + hstep, voffA);
        if (wr == 1) PG8_BAR;
        PG8_WAIT_V(4); PG8_BAR;
        PG8_STAGE(PG8_SB(1, 0), cB + kstep, voffB); PG8_STAGE(PG8_SA(1, 0), cA + kstep, voffA); PG8_STAGE(PG8_SB(1, 1), cB + hstep + kstep, voffB);
        PG8_WAIT_V(6); PG8_BAR;
    }
    for (;;) {
        const bool has_next = S.next(ui + 1, nxt);
        const char* nA = has_next ? (const char*)g.A + (size_t)nxt.pm * tstep : cA; const char* nB = has_next ? (const char*)g.Bt + (size_t)nxt.pn * tstep : cB;
        for (int t = 0; t < nt; t += 2) {
            const bool last = (t == nt - 2);
            if constexpr (Epi::MIDK) { if (t == E.midk_tile) E.midscale(acc, cur, wr, wc, fr, fq); }
            const char* a1 = cA + (size_t)(t + 1) * kstep;
            const char* a2 = last ? nA : cA + (size_t)(t + 2) * kstep; const char* b2 = last ? nB : cB + (size_t)(t + 2) * kstep;
            const char* a3 = a2 + kstep; const char* b3 = b2 + kstep;
            if (last && has_next) S.a_ready(nxt);
            if constexpr (SP2) {
            PG8_LDB(B0, 0, 0); PG8_LDB(B1, 0, 1); PG8_SCHED; PG8_LDA(At, 0, 0); PG8_STAGE(PG8_SA(1, 1), a1 + hstep, voffA);
            PG8_WAIT_V(8); PG8_WAIT_L(0); PG8_BAR; PG8_MMA(0, 0, At, B0); PG8_MMA(0, 1, At, B1); PG8_BAR; PG8_SCHED;
            PG8_LDA(At, 0, 1); PG8_STAGE(PG8_SB(0, 0), b2, voffB); PG8_STAGE(PG8_SB(0, 1), b2 + hstep, voffB); PG8_STAGE(PG8_SA(0, 0), a2, voffA);
            PG8_WAIT_V(8); PG8_WAIT_L(0); PG8_BAR; PG8_MMA(1, 0, At, B0); PG8_MMA(1, 1, At, B1); PG8_BAR; PG8_SCHED;
            PG8_LDB(B0, 1, 0); PG8_LDB(B1, 1, 1); PG8_SCHED; PG8_LDA(At, 1, 0); PG8_STAGE(PG8_SA(0, 1), a2 + hstep, voffA);
            PG8_WAIT_V(8); PG8_WAIT_L(0); PG8_BAR; PG8_MMA(0, 0, At, B0); PG8_MMA(0, 1, At, B1); PG8_BAR; PG8_SCHED;
            PG8_LDA(At, 1, 1); PG8_STAGE(PG8_SB(1, 0), b3, voffB); PG8_STAGE(PG8_SB(1, 1), b3 + hstep, voffB); PG8_STAGE(PG8_SA(1, 0), a3, voffA);
            PG8_WAIT_V(8); PG8_WAIT_L(0); PG8_BAR; PG8_MMA(1, 0, At, B0); PG8_MMA(1, 1, At, B1); PG8_BAR; PG8_SCHED;
            } else {
            PG8_LDB(B0, 0, 0); PG8_SCHED; PG8_LDA(At, 0, 0); PG8_STAGE(PG8_SA(1, 1), a1 + hstep, voffA);
            PG8_WAIT_L(8); PG8_BAR; PG8_WAIT_L(0); PG8_MMA(0, 0, At, B0); PG8_BAR; PG8_SCHED;
            PG8_LDB(B1, 0, 1); PG8_STAGE(PG8_SB(0, 0), b2, voffB);
            PG8_BAR; PG8_WAIT_L(0); PG8_MMA(0, 1, At, B1); PG8_BAR;
            PG8_LDA(At, 0, 1); PG8_STAGE(PG8_SA(0, 0), a2, voffA);
            PG8_BAR; PG8_WAIT_L(0); PG8_MMA(1, 0, At, B0); PG8_BAR; PG8_SCHED;
            PG8_STAGE(PG8_SB(0, 1), b2 + hstep, voffB);
            PG8_WAIT_V(6); PG8_BAR; PG8_MMA(1, 1, At, B1); PG8_BAR;
            PG8_LDB(B0, 1, 0); PG8_SCHED; PG8_LDA(At, 1, 0); PG8_STAGE(PG8_SA(0, 1), a2 + hstep, voffA);
            PG8_WAIT_L(8); PG8_BAR; PG8_WAIT_L(0); PG8_MMA(0, 0, At, B0); PG8_BAR; PG8_SCHED;
            PG8_LDB(B1, 1, 1); PG8_STAGE(PG8_SB(1, 0), b3, voffB);
            PG8_BAR; PG8_WAIT_L(0); PG8_MMA(0, 1, At, B1); PG8_BAR;
            PG8_LDA(At, 1, 1); PG8_STAGE(PG8_SA(1, 0), a3, voffA);
            PG8_BAR; PG8_WAIT_L(0); PG8_MMA(1, 0, At, B0); PG8_BAR; PG8_SCHED;
            PG8_STAGE(PG8_SB(1, 1), b3 + hstep, voffB);
            PG8_WAIT_V(6); PG8_BAR; PG8_MMA(1, 1, At, B1); PG8_BAR;
            }
        }
        if constexpr (ALIGN_EPI) { if (wr == 0) PG8_BAR; }
        if constexpr (!Epi::AFTER_DRAIN) { E(acc, cur, wr, wc, fr, fq); S.done(cur); }
        if (!has_next) break;
#pragma unroll
        for (int a = 0; a < 2; ++a)
#pragma unroll
            for (int b = 0; b < 2; ++b)
#pragma unroll
                for (int m = 0; m < 4; ++m)
#pragma unroll
                    for (int n = 0; n < 2; ++n) acc[a][b][m][n] = (f32x4){0.f, 0.f, 0.f, 0.f};
        cur = nxt; cA = nA; cB = nB; ++ui;
        if constexpr (ALIGN_EPI) { if (wr == 1) PG8_BAR; }
    }
    PG8_WAIT_V(0);
    if constexpr (!ALIGN_EPI) { if (wr == 0) PG8_BAR; }
    PG8_BAR;
    if constexpr (Epi::AFTER_DRAIN) { E.fused(acc, cur, wr, wc, fr, fq, lds, wid, lane); S.done(cur); }
#undef PG8_SA
#undef PG8_SB
#undef PG8_STAGE
#undef PG8_LDA
#undef PG8_LDB
#undef PG8_MMA
#undef PG8_WAIT_V
#undef PG8_WAIT_L
#undef PG8_BAR
#undef PG8_SCHED
}
}

typedef unsigned short bf16;
typedef unsigned v4u __attribute__((ext_vector_type(4)));
typedef float f32x4 __attribute__((ext_vector_type(4)));
#define GAS __attribute__((address_space(1)))
#define LDS_WAIT() asm volatile("s_waitcnt lgkmcnt(0)" ::: "memory")
#define VM_WAIT() asm volatile("s_waitcnt vmcnt(0)" ::: "memory")
__device__ __forceinline__ unsigned f2bf(float f) { unsigned u = __builtin_bit_cast(unsigned, f); return (u + 0x7fffu + ((u >> 16) & 1u)) >> 16; }
__device__ __forceinline__ unsigned pk2(float lo, float hi) { return f2bf(lo) | (f2bf(hi) << 16); }
__device__ __forceinline__ float bf2f(unsigned short v) { return __builtin_bit_cast(float, (unsigned)v << 16); }

struct Frame {
    LAS unsigned char* lds;
    int nvb;
    int wave, G, vcu;
    unsigned* ctl;
    float* modp; bf16* w_in_t; bf16* h1b; bf16* w_out_t; bf16* wr_t; bf16* ws_down_t; bf16* ycatb; bf16* h2b; bf16* sactb; float* rsg; bf16* actb; bf16* contribb; bf16* projb; float* ssq; bf16* qrb; bf16* krb; float* UT; bf16* RT; bf16* x1b;
    const float *x, *c, *w_ada, *b_ada, *w_in, *rel_bias, *attn_gain, *ret_gain, *w_out, *ln1_g, *ln1_b, *w_router, *router_bias, *w_gate, *w_up, *w_down, *ws_gate, *ws_up, *ws_down, *ln2_g, *ln2_b;
    float* out;
    int* counts; float* mod; float* cs; float* h1; float* proj; float* qr; float* kr; float* attn_out; float* U; float* R; float* ycat; float* mixer; float* x1; float* h2;
    float* logits; int* lists; int* a_exp; float* a_w; float* act; float* contrib; float* sgu; float* sact; float* sh_out;
};
#define VB_FOR(u, N) for (int _b = (int)blockIdx.x * 2, u = _b + (F.wave >> 2); _b < (N); _b += (int)gridDim.x * 2, u = _b + (F.wave >> 2))

__device__ __forceinline__ void ph_gemm(Frame& F, const float* __restrict__ A, int lda, const float* __restrict__ B, int ldb, float* __restrict__ C, int ldc, int M, int N, int K) {
    LAS float* As = (LAS float*)(F.lds + (F.wave >> 2) * 16384);
    LAS float* Bs = As + 16 * 68;
    const int tid = ((F.wave & 3) * 64 + lane_id()), tx = tid & 15, ty = tid >> 4, ntn = N / 64, ntiles = (M / 64) * ntn;
    VB_FOR(u, ntiles) {
        const int m0 = (u / ntn) * 64, n0 = (u % ntn) * 64;
        float acc[4][4];
#pragma unroll
        for (int i = 0; i < 4; ++i)
#pragma unroll
            for (int j = 0; j < 4; ++j) acc[i][j] = 0.f;
        for (int k0 = 0; k0 < K; k0 += 16) {
            {
                const int r = tid >> 2, c4 = (tid & 3) * 4;
                const float4 v = *(const float4*)(A + (size_t)(m0 + r) * lda + k0 + c4);
                As[(c4 + 0) * 68 + r] = v.x; As[(c4 + 1) * 68 + r] = v.y; As[(c4 + 2) * 68 + r] = v.z; As[(c4 + 3) * 68 + r] = v.w;
                const int kr = tid >> 4, cc = (tid & 15) * 4;
                const float4 w = *(const float4*)(B + (size_t)(k0 + kr) * ldb + n0 + cc);
                Bs[kr * 68 + cc + 0] = w.x; Bs[kr * 68 + cc + 1] = w.y; Bs[kr * 68 + cc + 2] = w.z; Bs[kr * 68 + cc + 3] = w.w;
            }
            __syncthreads();
#pragma unroll
            for (int kk = 0; kk < 16; ++kk) {
                float a[4], b[4];
#pragma unroll
                for (int i = 0; i < 4; ++i) a[i] = As[kk * 68 + ty * 4 + i];
#pragma unroll
                for (int j = 0; j < 4; ++j) b[j] = Bs[kk * 68 + tx * 4 + j];
#pragma unroll
                for (int i = 0; i < 4; ++i)
#pragma unroll
                    for (int j = 0; j < 4; ++j) acc[i][j] += a[i] * b[j];
            }
            __syncthreads();
        }
#pragma unroll
        for (int i = 0; i < 4; ++i)
#pragma unroll
            for (int j = 0; j < 4; ++j) C[(size_t)(m0 + ty * 4 + i) * ldc + n0 + tx * 4 + j] = acc[i][j];
    }
}

__device__ __forceinline__ void ph_mod_rope(Frame& F) {
    const int gt = (int)blockIdx.x * 512 + (F.wave * 64 + lane_id()), GT = (int)gridDim.x * 512;
    for (int i = gt; i < 2 * 6 * D_MODEL; i += GT) {
        const int b = i / (6 * D_MODEL), n = i % (6 * D_MODEL);
        float acc = 0.f;
        for (int k = 0; k < D_MODEL; ++k) acc += silu_f(F.c[b * D_MODEL + k]) * F.w_ada[(size_t)k * (6 * D_MODEL) + n];
        F.mod[i] = acc + F.b_ada[n];
    }
    for (int i = gt; i < SEQ * 32; i += GT) {
        const int s = i >> 5, j = i & 31;
        const float inv = powf(10000.0f, -(float)j / 32.0f);
        const float ang = (float)s * inv;
        F.cs[2 * i] = cosf(ang); F.cs[2 * i + 1] = sinf(ang);
    }
}
__device__ __forceinline__ void ph_modulate(Frame& F) {
    const size_t gt = (size_t)blockIdx.x * 512 + (F.wave * 64 + lane_id()), GT = (size_t)gridDim.x * 512;
    for (size_t i = gt; i < (size_t)NTOK * D_MODEL; i += GT) {
        const int t = (int)(i / D_MODEL), d = (int)(i % D_MODEL), b = t / SEQ;
        F.h1[i] = F.x[i] * (1.0f + F.mod[b * 6 * D_MODEL + D_MODEL + d]) + F.mod[b * 6 * D_MODEL + d];
    }
}
__device__ __forceinline__ void ph_band_attn(Frame& F) {
    const float* __restrict__ proj = F.proj;
    VB_FOR(u, 1024) {
        const int c = u & 63, h = (u >> 6) & 7, b = u >> 9;
        const int tid = ((F.wave & 3) * 64 + lane_id()), i = tid >> 2, part = tid & 3;
        const size_t tq = (size_t)b * SEQ + c * 64 + i;
        float q[32], o[32];
        const float scale = 0.08838834764831845f;
#pragma unroll
        for (int d = 0; d < 32; ++d) { q[d] = proj[tq * IN_WIDTH + h * 128 + part * 32 + d] * scale; o[d] = 0.f; }
        float m = -1e30f, l = 0.f;
        for (int j = 0; j < 576; ++j) {
            const int kpos = c * 64 - 512 + j;
            if (kpos < 0) continue;
            const size_t tk = (size_t)b * SEQ + kpos;
            const float* kp = proj + tk * IN_WIDTH + 1024 + h * 128 + part * 32;
            float s = 0.f;
#pragma unroll
            for (int d = 0; d < 32; ++d) s += q[d] * kp[d];
            s += __shfl_xor(s, 1); s += __shfl_xor(s, 2);
            int dist = 512 + i - j; dist = dist < -63 ? -63 : (dist > 256 ? 256 : dist);
            s += F.rel_bias[h * 320 + dist + 63];
            const float mn = fmaxf(m, s), a = __expf(m - mn), p = __expf(s - mn);
            l = l * a + p; m = mn;
            const float* vp = proj + tk * IN_WIDTH + 2048 + h * 128 + part * 32;
#pragma unroll
            for (int d = 0; d < 32; ++d) o[d] = o[d] * a + p * vp[d];
        }
        const float il = 1.0f / l;
#pragma unroll
        for (int d = 0; d < 32; ++d) F.attn_out[tq * 1024 + h * 128 + part * 32 + d] = o[d] * il;
    }
}
__device__ __forceinline__ void ph_rot(Frame& F) {
    const size_t gt = (size_t)blockIdx.x * 512 + (F.wave * 64 + lane_id()), GT = (size_t)gridDim.x * 512;
    for (size_t i = gt; i < (size_t)NTOK * 256; i += GT) {
        const int j = (int)(i & 31), h = (int)((i >> 5) & 7); const size_t t = i >> 8; const int s = (int)(t % SEQ);
        const float co = F.cs[(s * 32 + j) * 2], si = F.cs[(s * 32 + j) * 2 + 1];
        const bf16* pq = F.projb + t * IN_WIDTH + 3072 + h * 64; const bf16* pk = F.projb + t * IN_WIDTH + 3584 + h * 64;
        const float q1 = bf2f(pq[j]), q2 = bf2f(pq[j + 32]), k1 = bf2f(pk[j]), k2 = bf2f(pk[j + 32]);
        F.qr[t * 512 + h * 64 + j] = q1 * co - q2 * si; F.qr[t * 512 + h * 64 + 32 + j] = q2 * co + q1 * si;
        F.kr[t * 512 + h * 64 + j] = (k1 * co - k2 * si) * 0.125f; F.kr[t * 512 + h * 64 + 32 + j] = (k2 * co + k1 * si) * 0.125f;
    }
}
__device__ __forceinline__ void ph_rms(Frame& F) {
    const int lane = (F.wave * 64 + lane_id()) & 63, gw = (int)blockIdx.x * 8 + ((F.wave * 64 + lane_id()) >> 6), GW = (int)gridDim.x * 8;
    for (int t = gw; t < NTOK; t += GW) {
        float v[16]; float ss = 0.f;
#pragma unroll
        for (int j = 0; j < 16; ++j) { v[j] = F.attn_out[(size_t)t * 1024 + lane + 64 * j]; ss += v[j] * v[j]; }
        for (int o = 32; o > 0; o >>= 1) ss += __shfl_xor(ss, o);
        const float rs = rsqrtf(ss / 1024.0f + EPS_F);
#pragma unroll
        for (int j = 0; j < 16; ++j) F.ycatb[(size_t)t * D_MODEL + lane + 64 * j] = (bf16)f2bf(v[j] * rs * F.attn_gain[lane + 64 * j]);
    }
}
__device__ __forceinline__ void ph_ret_u(Frame& F) {
    VB_FOR(u, 1024) {
        const int c = u & 63, h = (u >> 6) & 7, b = u >> 9, tid = ((F.wave & 3) * 64 + lane_id()), kk = tid >> 2, part = tid & 3;
        const float lg = log_gamma(h);
        float acc[32];
#pragma unroll
        for (int d = 0; d < 32; ++d) acc[d] = 0.f;
        for (int m = 0; m < 64; ++m) {
            const size_t t = (size_t)b * SEQ + c * 64 + m;
            const float kv = F.kr[t * 512 + h * 64 + kk] * __expf(lg * (float)(63 - m));
            const bf16* vp = F.projb + t * IN_WIDTH + 4096 + h * 128 + part * 32;
#pragma unroll
            for (int d = 0; d < 32; ++d) acc[d] += kv * bf2f(vp[d]);
        }
        float* up = F.U + ((((size_t)b * 8 + h) * 64 + c) * 64 + kk) * 128 + part * 32;
#pragma unroll
        for (int d = 0; d < 32; ++d) up[d] = acc[d];
    }
}
__device__ __forceinline__ void ph_ret_scan(Frame& F) {
    const int gt = (int)blockIdx.x * 512 + (F.wave * 64 + lane_id()), GT = (int)gridDim.x * 512;
    for (int i = gt; i < 2 * 8 * 8192; i += GT) {
        const int e = i & 8191, bh = i >> 13, h = bh & 7;
        const float g = __expf(log_gamma(h) * 64.0f);
        float st = 0.f;
        for (int c = 0; c < 64; ++c) { const size_t o = ((size_t)bh * 64 + c) * 8192 + e; F.R[o] = st; st = g * st + F.U[o]; }
    }
}
__device__ __forceinline__ void ph_ret_out(Frame& F) {
    VB_FOR(u, 1024) {
        const int c = u & 63, h = (u >> 6) & 7, b = u >> 9, tid = ((F.wave & 3) * 64 + lane_id()), n = tid >> 2, part = tid & 3;
        const float lg = log_gamma(h);
        const size_t tn = (size_t)b * SEQ + c * 64 + n;
        float q[16], o[32];
#pragma unroll
        for (int d = 0; d < 16; ++d) q[d] = F.qr[tn * 512 + h * 64 + part * 16 + d];
#pragma unroll
        for (int d = 0; d < 32; ++d) o[d] = 0.f;
        for (int m = 0; m < 64; ++m) {
            const size_t tm = (size_t)b * SEQ + c * 64 + m;
            const float* kp = F.kr + tm * 512 + h * 64 + part * 16;
            float s = 0.f;
#pragma unroll
            for (int d = 0; d < 16; ++d) s += q[d] * kp[d];
            s += __shfl_xor(s, 1); s += __shfl_xor(s, 2);
            const int dd = n > m ? n - m : m - n;
            s *= __expf(lg * (float)dd);
            const bf16* vp = F.projb + tm * IN_WIDTH + 4096 + h * 128 + part * 32;
#pragma unroll
            for (int d = 0; d < 32; ++d) o[d] += s * bf2f(vp[d]);
        }
        const float xi = __expf(lg * (float)(n + 1));
        const float* Rp = F.R + (((size_t)b * 8 + h) * 64 + c) * 8192;
        for (int kk = 0; kk < 64; ++kk) {
            const float qv = F.qr[tn * 512 + h * 64 + kk] * xi;
            const float* rp = Rp + kk * 128 + part * 32;
#pragma unroll
            for (int d = 0; d < 32; ++d) o[d] += qv * rp[d];
        }
        float s1 = 0.f;
#pragma unroll
        for (int d = 0; d < 32; ++d) s1 += o[d];
        s1 += __shfl_xor(s1, 1); s1 += __shfl_xor(s1, 2);
        const float mu = s1 / 128.0f; float s2 = 0.f;
#pragma unroll
        for (int d = 0; d < 32; ++d) { const float dv = o[d] - mu; s2 += dv * dv; }
        s2 += __shfl_xor(s2, 1); s2 += __shfl_xor(s2, 2);
        const float rs = rsqrtf(s2 / 128.0f + EPS_F);
#pragma unroll
        for (int d = 0; d < 32; ++d) {
            const int col = h * 128 + part * 32 + d;
            const float gb = bf2f(F.projb[tn * IN_WIDTH + 5120 + col]);
            F.ycatb[tn * D_MODEL + 1024 + col] = (bf16)f2bf(silu_f(gb) * (o[d] - mu) * rs * F.ret_gain[col]);
        }
    }
}
__device__ __forceinline__ void ph_res_ln(Frame& F, const float* __restrict__ xres, const float* __restrict__ y, const bf16* __restrict__ contrib, int g_off,
                                          const float* __restrict__ gain, const float* __restrict__ bias, float* __restrict__ xo, int sh_off, int sc_off, float* __restrict__ hmod) {
    const int lane = (F.wave * 64 + lane_id()) & 63, gw = (int)blockIdx.x * 8 + ((F.wave * 64 + lane_id()) >> 6), GW = (int)gridDim.x * 8;
    for (int t = gw; t < NTOK; t += GW) {
        const int b = t / SEQ;
        float z[32]; float s = 0.f;
#pragma unroll
        for (int j = 0; j < 32; ++j) {
            const int d = lane + 64 * j; float yy = y[(size_t)t * D_MODEL + d];
            if (contrib) {
#pragma unroll
                for (int k = 0; k < 8; ++k) yy += bf2f(contrib[((size_t)t * 8 + k) * D_MODEL + d]);
            }
            z[j] = ALPHA_F * xres[(size_t)t * D_MODEL + d] + F.mod[b * 6 * D_MODEL + g_off + d] * yy; s += z[j];
        }
        for (int o = 32; o > 0; o >>= 1) s += __shfl_xor(s, o);
        const float mu = s / (float)D_MODEL; float q = 0.f;
#pragma unroll
        for (int j = 0; j < 32; ++j) { const float dv = z[j] - mu; q += dv * dv; }
        for (int o = 32; o > 0; o >>= 1) q += __shfl_xor(q, o);
        const float rs = rsqrtf(q / (float)D_MODEL + EPS_F);
#pragma unroll
        for (int j = 0; j < 32; ++j) {
            const int d = lane + 64 * j; const float v = (z[j] - mu) * rs * gain[d] + bias[d];
            xo[(size_t)t * D_MODEL + d] = v;
            if (hmod) { const float hv = v * (1.0f + F.mod[b * 6 * D_MODEL + sc_off + d]) + F.mod[b * 6 * D_MODEL + sh_off + d]; hmod[(size_t)t * D_MODEL + d] = hv; F.h2b[(size_t)t * D_MODEL + d] = (bf16)f2bf(hv); }
        }
    }
}
__device__ __forceinline__ void ph_route(Frame& F) {
    LAS float* sb = (LAS float*)(F.lds + (F.wave >> 2) * 4096); LAS float* ssc = sb + 256; LAS float* gs = ssc + 256; LAS int* gsel = (LAS int*)(gs + 8); LAS int* pick = gsel + 8;
    const int e = ((F.wave & 3) * 64 + lane_id());
    VB_FOR(t, NTOK) {
        const float sc = sigmoid_f(F.rsg[(size_t)t * 768 + e]); const float bi = sc + F.router_bias[e];
        __syncthreads();
        ssc[e] = sc; sb[e] = bi;
        __syncthreads();
        if (e < 8) { float t1 = -1e30f, t2 = -1e30f; for (int i = 0; i < 32; ++i) { const float v = sb[e * 32 + i]; if (v > t1) { t2 = t1; t1 = v; } else if (v > t2) t2 = v; } gs[e] = t1 + t2; gsel[e] = 0; }
        __syncthreads();
        if (e == 0) {
            for (int r = 0; r < 4; ++r) { int bi_ = 0; float bv = -1e30f; for (int g = 0; g < 8; ++g) if (!gsel[g] && gs[g] > bv) { bv = gs[g]; bi_ = g; } gsel[bi_] = 1; }
        }
        __syncthreads();
        if (!gsel[e >> 5]) sb[e] = -1e30f;
        __syncthreads();
        if (e == 0) {
            float wsum = 0.f;
            for (int r = 0; r < 8; ++r) { int bi_ = 0; float bv = -2e30f; for (int i = 0; i < 256; ++i) if (sb[i] > bv) { bv = sb[i]; bi_ = i; } pick[r] = bi_; sb[bi_] = -3e30f; wsum += ssc[bi_]; }
            for (int r = 0; r < 8; ++r) {
                const int ex = pick[r]; const int slot = atomicAdd(&F.counts[ex], 1);
                F.lists[ex * NTOK + slot] = t * 8 + r; F.a_exp[t * 8 + r] = ex; F.a_w[t * 8 + r] = ssc[ex] / wsum * 2.5f;
            }
        }
    }
}
__device__ __forceinline__ void ph_swiglu_act(Frame& F) {
    const size_t gt = (size_t)blockIdx.x * 512 + (F.wave * 64 + lane_id()), GT = (size_t)gridDim.x * 512;
    for (size_t i = gt; i < (size_t)NTOK * 256; i += GT) { const size_t t = i >> 8; const int j = (int)(i & 255); F.sactb[i] = (bf16)f2bf(silu_f(F.rsg[t * 768 + 256 + j]) * F.rsg[t * 768 + 512 + j]); }
}
__device__ __forceinline__ void ph_moe_gu(Frame& F) {
    LAS float* hs = (LAS float*)(F.lds + (F.wave >> 2) * 8192);
    const int j = ((F.wave & 3) * 64 + lane_id());
    for (int e = blockIdx.x; e < NEXP; e += gridDim.x) {
        const int cnt = F.counts[e];
        const float* wgp = F.w_gate + (size_t)e * D_MODEL * EDIM; const float* wup = F.w_up + (size_t)e * D_MODEL * EDIM;
        for (int t0 = 0; t0 < cnt; t0 += 16) {
            const int tile0 = t0 + (F.wave >> 2) * 8;
            int aid[8];
#pragma unroll
            for (int i = 0; i < 8; ++i) { const int s = tile0 + i; aid[i] = s < cnt ? F.lists[e * NTOK + s] : -1; }
            float ag[8], au[8];
#pragma unroll
            for (int i = 0; i < 8; ++i) { ag[i] = 0.f; au[i] = 0.f; }
            for (int k0 = 0; k0 < D_MODEL; k0 += 256) {
                __syncthreads();
#pragma unroll
                for (int i = 0; i < 8; ++i) hs[i * 256 + j] = aid[i] >= 0 ? F.h2[(size_t)(aid[i] >> 3) * D_MODEL + k0 + j] : 0.f;
                __syncthreads();
                for (int kk = 0; kk < 256; ++kk) {
                    const float a = wgp[(size_t)(k0 + kk) * EDIM + j], u = wup[(size_t)(k0 + kk) * EDIM + j];
#pragma unroll
                    for (int i = 0; i < 8; ++i) { const float hv = hs[i * 256 + kk]; ag[i] += hv * a; au[i] += hv * u; }
                }
            }
#pragma unroll
            for (int i = 0; i < 8; ++i) if (aid[i] >= 0) F.act[(size_t)aid[i] * EDIM + j] = silu_f(ag[i]) * au[i];
        }
    }
}
__device__ __forceinline__ void ph_moe_down(Frame& F) {
    LAS float* as = (LAS float*)(F.lds + (F.wave >> 2) * 8192);
    const int j = ((F.wave & 3) * 64 + lane_id());
    for (int e = blockIdx.x; e < NEXP; e += gridDim.x) {
        const int cnt = F.counts[e];
        for (int t0 = 0; t0 < cnt; t0 += 16) {
            const int tile0 = t0 + (F.wave >> 2) * 8;
            int aid[8];
#pragma unroll
            for (int i = 0; i < 8; ++i) { const int s = tile0 + i; aid[i] = s < cnt ? F.lists[e * NTOK + s] : -1; }
            __syncthreads();
#pragma unroll
            for (int i = 0; i < 8; ++i) as[i * 256 + j] = aid[i] >= 0 ? F.act[(size_t)aid[i] * EDIM + j] : 0.f;
            __syncthreads();
            for (int half = 0; half < 2; ++half) {
                float acc[4][8];
#pragma unroll
                for (int c = 0; c < 4; ++c)
#pragma unroll
                    for (int i = 0; i < 8; ++i) acc[c][i] = 0.f;
                const float* wp = F.w_down + (size_t)e * EDIM * D_MODEL + half * 1024 + j;
                for (int kk = 0; kk < 256; ++kk) {
                    float w[4];
#pragma unroll
                    for (int c = 0; c < 4; ++c) w[c] = wp[(size_t)kk * D_MODEL + 256 * c];
#pragma unroll
                    for (int i = 0; i < 8; ++i) { const float a = as[i * 256 + kk];
#pragma unroll
                        for (int c = 0; c < 4; ++c) acc[c][i] += a * w[c]; }
                }
#pragma unroll
                for (int i = 0; i < 8; ++i) if (aid[i] >= 0) { const float rw = F.a_w[aid[i]];
#pragma unroll
                    for (int c = 0; c < 4; ++c) F.contrib[(size_t)aid[i] * D_MODEL + half * 1024 + j + 256 * c] = rw * acc[c][i]; }
            }
        }
    }
}


__device__ __forceinline__ float wave_sum(float v) {
#pragma unroll
    for (int o = 1; o < 64; o <<= 1) v += __shfl_xor(v, o);
    return v;
}
__device__ __forceinline__ void p0_transpose_item(const float* W, int K, int N, bf16* WT, int row_off, LAS float* scr, int item, int lane) {
    const int nblk = N / 32, kb = item / nblk, nb = item % nblk, k0 = 64 * kb, n0 = 32 * nb;
#pragma unroll 8
    for (int i = 0; i < 32; ++i) { const int kk = 2 * i + (lane >> 5); scr[kk * 33 + (lane & 31)] = W[(size_t)(k0 + kk) * N + n0 + (lane & 31)]; }
    LDS_WAIT(); asm volatile("" ::: "memory");
    const int c = lane & 7;
#pragma unroll
    for (int j = 0; j < 4; ++j) { const int n = (lane >> 3) + 8 * j; const LAS float* s = scr + (8 * c) * 33 + n;
        v4u o; o.x = pk2(s[0 * 33], s[1 * 33]); o.y = pk2(s[2 * 33], s[3 * 33]); o.z = pk2(s[4 * 33], s[5 * 33]); o.w = pk2(s[6 * 33], s[7 * 33]);
        *(GAS v4u*)(WT + (size_t)(row_off + n0 + n) * K + k0 + 8 * c) = o; }
    LDS_WAIT(); asm volatile("" ::: "memory");
}
constexpr int CW_MODCNT = 12288;
__device__ __forceinline__ void p0_mod(Frame& F) {
    LAS float* red = (LAS float*)F.lds;
    volatile LAS unsigned* flag = (volatile LAS unsigned*)(F.lds + 65536);
    for (int p = blockIdx.x; p < 256; p += gridDim.x) {
        const int kr = p >> 4, cb = p & 15;
        f32x4 acc[2][3];
#pragma unroll
        for (int b = 0; b < 2; ++b)
#pragma unroll
            for (int j = 0; j < 3; ++j) acc[b][j] = (f32x4){0.f, 0.f, 0.f, 0.f};
        const int kbase = kr * 128 + F.wave * 16;
#pragma unroll 4
        for (int i = 0; i < 16; ++i) {
            const int k = kbase + i;
            const float s0 = silu_f(F.c[k]), s1 = silu_f(F.c[D_MODEL + k]);
            const float* wp = F.w_ada + (size_t)k * (6 * D_MODEL) + cb * 768 + lane_id() * 4;
#pragma unroll
            for (int j = 0; j < 3; ++j) { const f32x4 w = *(const f32x4*)(wp + j * 256); acc[0][j] += w * s0; acc[1][j] += w * s1; }
        }
        __syncthreads();
#pragma unroll
        for (int b = 0; b < 2; ++b)
#pragma unroll
            for (int j = 0; j < 3; ++j) *(LAS f32x4*)(red + (F.wave * 2 + b) * 768 + j * 256 + lane_id() * 4) = acc[b][j];
        __syncthreads();
        for (int o = (F.wave * 64 + lane_id()); o < 1536; o += 512) {
            const int b = o / 768, n = o % 768; float s = 0.f;
#pragma unroll
            for (int w = 0; w < 8; ++w) s += red[(w * 2 + b) * 768 + n];
            F.modp[((size_t)kr * 2 + b) * (6 * D_MODEL) + cb * 768 + n] = s;
        }
        asm volatile("s_waitcnt vmcnt(0)" ::: "memory");
        __syncthreads();
        if ((F.wave * 64 + lane_id()) == 0) {
            __builtin_amdgcn_fence(__ATOMIC_RELEASE, "agent");
            asm volatile("s_waitcnt vmcnt(0)" ::: "memory");
            const unsigned old = __hip_atomic_fetch_add(F.ctl + CW_MODCNT + 64 * cb, 1u, __ATOMIC_RELAXED, __HIP_MEMORY_SCOPE_AGENT);
            const unsigned last = (old == 15u) ? 1u : 0u;
            if (last) { __builtin_amdgcn_fence(__ATOMIC_ACQUIRE, "agent"); asm volatile("s_waitcnt vmcnt(0)" ::: "memory"); }
            flag[0] = last;
        }
        __syncthreads();
        if (flag[0]) {
            for (int o = (F.wave * 64 + lane_id()); o < 1536; o += 512) {
                const int b = o / 768, n = cb * 768 + o % 768; float s = F.b_ada[n];
#pragma unroll
                for (int r = 0; r < 16; ++r) s += F.modp[((size_t)r * 2 + b) * (6 * D_MODEL) + n];
                F.mod[b * 6 * D_MODEL + n] = s;
            }
        }
        __syncthreads();
    }
}
__device__ __forceinline__ void p0_prologue(Frame& F) {
    p0_mod(F);
    { const int gt = (int)blockIdx.x * 512 + (F.wave * 64 + lane_id()), GT = (int)gridDim.x * 512;
      for (int i = gt; i < SEQ * 32; i += GT) { const int s = i >> 5, j = i & 31; const float inv = powf(10000.0f, -(float)j / 32.0f); const float ang = (float)s * inv; F.cs[2 * i] = cosf(ang); F.cs[2 * i + 1] = sinf(ang); } }
    __syncthreads();
    LAS float* scr = (LAS float*)(F.lds + F.wave * 16384);
    const int gw = F.vcu * 8 + F.wave, NGW = F.G * 8;
    constexpr int I_IN = (D_MODEL / 64) * (IN_WIDTH / 32);
    constexpr int I_OUT = (D_MODEL / 64) * (D_MODEL / 32), I_R = (D_MODEL / 64) * (256 / 32), I_D = (256 / 64) * (D_MODEL / 32);
    constexpr int NITEMS = I_IN + I_OUT + 3 * I_R + I_D;
    for (int it = gw; it < NITEMS; it += NGW) {
        int r = it;
        if (r < I_IN) { p0_transpose_item(F.w_in, D_MODEL, IN_WIDTH, F.w_in_t, 0, scr, r, lane_id()); continue; } r -= I_IN;
        if (r < I_OUT) { p0_transpose_item(F.w_out, D_MODEL, D_MODEL, F.w_out_t, 0, scr, r, lane_id()); continue; } r -= I_OUT;
        if (r < I_R) { p0_transpose_item(F.w_router, D_MODEL, 256, F.wr_t, 0, scr, r, lane_id()); continue; } r -= I_R;
        if (r < I_R) { p0_transpose_item(F.ws_gate, D_MODEL, 256, F.wr_t, 256, scr, r, lane_id()); continue; } r -= I_R;
        if (r < I_R) { p0_transpose_item(F.ws_up, D_MODEL, 256, F.wr_t, 512, scr, r, lane_id()); continue; } r -= I_R;
        p0_transpose_item(F.ws_down, 256, D_MODEL, F.ws_down_t, 0, scr, r, lane_id());
    }
}
__device__ __forceinline__ void p1_modulate_bf16(Frame& F) {
    const size_t gt = (size_t)blockIdx.x * 512 + (F.wave * 64 + lane_id()), GT = (size_t)gridDim.x * 512;
    for (size_t i = gt; i < (size_t)NTOK * D_MODEL / 8; i += GT) {
        const size_t e = i * 8; const int t = (int)(e / D_MODEL), d = (int)(e % D_MODEL), b = t / SEQ;
        const f32x4 x0 = *(const f32x4*)(F.x + e), x1 = *(const f32x4*)(F.x + e + 4);
        const float* mb = F.mod + b * 6 * D_MODEL;
        const f32x4 sh0 = *(const f32x4*)(mb + d), sh1 = *(const f32x4*)(mb + d + 4), sc0 = *(const f32x4*)(mb + D_MODEL + d), sc1 = *(const f32x4*)(mb + D_MODEL + d + 4);
        const f32x4 h0 = x0 * (sc0 + 1.0f) + sh0, h1 = x1 * (sc1 + 1.0f) + sh1;
        v4u o; o.x = pk2(h0[0], h0[1]); o.y = pk2(h0[2], h0[3]); o.z = pk2(h1[0], h1[1]); o.w = pk2(h1[2], h1[3]);
        *(v4u*)(F.h1b + e) = o;
    }
}

typedef float f32x16 __attribute__((ext_vector_type(16)));
typedef short bf16x8 __attribute__((ext_vector_type(8)));
constexpr int MOE_MC = 384, MOE_ABUF = MOE_MC * 128, MOE_BBUF = 128 * 128;
constexpr int MOE_TAB = 131072 + 1024;
constexpr int CW_QHEAD = 13440;
__device__ __forceinline__ void glds16_asm(const void* gsrc, unsigned lds_dst) {
    unsigned keep;
    asm volatile("s_mov_b32 %0, m0\n\ts_mov_b32 m0, %2\n\ts_nop 0\n\tglobal_load_lds_dwordx4 %1, off\n\ts_mov_b32 m0, %0" : "=&s"(keep) : "v"(gsrc), "s"(lds_dst) : "memory");
}
#define MOE_WAITV(n) asm volatile("s_waitcnt vmcnt(" #n ")" ::: "memory")

__device__ __forceinline__ void moe_tables(Frame& F) {
    LAS int* cnt = (LAS int*)(F.lds + MOE_TAB); LAS int* order = cnt + 256; LAS int* offs = order + 256; LAS int* pre = offs + 256;
    const int tid = F.wave * 64 + lane_id();
    __syncthreads();
    if (tid < 256) cnt[tid] = F.counts[tid];
    __syncthreads();
    if (tid < 256) {
        const int me = cnt[tid]; int rank = 0, p = 0;
        for (int j = 0; j < 256; ++j) { const int cj = cnt[j]; rank += (cj > me || (cj == me && j < tid)) ? 1 : 0; p += (j < tid) ? cj : 0; }
        order[rank] = tid; offs[tid] = p;
    }
    __syncthreads();
    LAS int* nchl = pre + 264;
    if (tid < 256) nchl[tid] = (cnt[order[tid]] + MOE_MC - 1) / MOE_MC;
    __syncthreads();
    if (tid < 256) {
        int p = 0;
        for (int j = 0; j < 256; ++j) p += (j < tid) ? nchl[j] : 0;
        pre[tid] = p;
        if (tid == 255) pre[256] = p + nchl[255];
    }
    __syncthreads();
}

template <int MODE, int MYN>
__device__ __forceinline__ void moe_epilogue(Frame& F, f32x16 (&acc)[3][2], const int e, const int slice, const int sp, const int chunk_base, const int nrows, const int row_off,
                                             const int l, const int cp, const int rg, const int h, const bool zero_acc = true) {
#pragma unroll
    for (int i = 0; i < 3; ++i) if (i < MYN) {
        const int R = (rg + 4 * i) * 32 + (l & 31); const bool valid = R < nrows;
        if (MODE == 0) {
            bf16* dst = F.actb + (size_t)(row_off + chunk_base + R) * EDIM + 64 * slice + 32 * cp + 8 * h;
#pragma unroll
            for (int g = 0; g < 4; g += 2) {
                unsigned a0, a1, b0, b1;
                { float v[4];
#pragma unroll
                  for (int j = 0; j < 4; ++j) v[j] = silu_f(acc[i][0][4 * g + j]) * acc[i][1][4 * g + j];
                  a0 = pg8::cvt_pk_bf16(v[0], v[1]); a1 = pg8::cvt_pk_bf16(v[2], v[3]); }
                { float v[4];
#pragma unroll
                  for (int j = 0; j < 4; ++j) v[j] = silu_f(acc[i][0][4 * g + 4 + j]) * acc[i][1][4 * g + 4 + j];
                  b0 = pg8::cvt_pk_bf16(v[0], v[1]); b1 = pg8::cvt_pk_bf16(v[2], v[3]); }
                const auto r0 = __builtin_amdgcn_permlane32_swap(a0, b0, false, false); const auto r1 = __builtin_amdgcn_permlane32_swap(a1, b1, false, false);
                v4u o; o.x = r0[0]; o.y = r1[0]; o.z = r0[1]; o.w = r1[1];
                if (valid) *(v4u*)(dst + 8 * g) = o;
            }
        } else {
            const int aid = F.lists[e * NTOK + chunk_base + (valid ? R : 0)]; const float wt = F.a_w[aid];
            bf16* dst = F.contribb + (size_t)aid * D_MODEL + 512 * slice + 128 * sp + cp * 64 + 8 * h;
#pragma unroll
            for (int c = 0; c < 2; ++c)
#pragma unroll
                for (int g = 0; g < 4; g += 2) {
                    const unsigned a0 = pg8::cvt_pk_bf16(acc[i][c][4 * g] * wt, acc[i][c][4 * g + 1] * wt), a1 = pg8::cvt_pk_bf16(acc[i][c][4 * g + 2] * wt, acc[i][c][4 * g + 3] * wt);
                    const unsigned b0 = pg8::cvt_pk_bf16(acc[i][c][4 * g + 4] * wt, acc[i][c][4 * g + 5] * wt), b1 = pg8::cvt_pk_bf16(acc[i][c][4 * g + 6] * wt, acc[i][c][4 * g + 7] * wt);
                    const auto r0 = __builtin_amdgcn_permlane32_swap(a0, b0, false, false); const auto r1 = __builtin_amdgcn_permlane32_swap(a1, b1, false, false);
                    v4u o; o.x = r0[0]; o.y = r1[0]; o.z = r0[1]; o.w = r1[1];
                    if (valid) *(v4u*)(dst + 32 * c + 8 * g) = o;
                }
        }
    }
    if (zero_acc)
#pragma unroll
    for (int i = 0; i < 3; ++i)
#pragma unroll
        for (int c = 0; c < 2; ++c)
#pragma unroll
            for (int q = 0; q < 16; ++q) acc[i][c][q] = 0.f;
}

#ifndef MOE_PROBE
#define MOE_PROBE 0
#endif
#if MOE_PROBE == 2
#define MOE_PROBE_MFMA_BLOCK { const int l2 = lane_id(), h2 = l2 >> 5, fsw2 = l2 & 7; bf16x8 wz; _Pragma("unroll") for (int q_ = 0; q_ < 8; ++q_) wz[q_] = 0; asm volatile("" : "+v"(wz)); \
          const LAS unsigned char* ab = lds + (tau & 1) * MOE_ABUF + (unsigned)((rg * 32 + (l2 & 31)) * 128); \
          _Pragma("unroll") for (int s = 0; s < 4; ++s) { const int co = ((2 * s + h2) ^ fsw2) << 4; \
              _Pragma("unroll") for (int i = 0; i < 3; ++i) if (i < MYN) { const bf16x8 tf = *(const LAS bf16x8*)(ab + i * (4 * 32 * 128) + co); \
                  acc[i][0] = __builtin_amdgcn_mfma_f32_32x32x16_bf16(wz, tf, acc[i][0], 0, 0, 0); \
                  acc[i][1] = __builtin_amdgcn_mfma_f32_32x32x16_bf16(wz, tf, acc[i][1], 0, 0, 0); } } }
#else
#define MOE_PROBE_MFMA_BLOCK
#endif
#if MOE_PROBE == 3
#define MOE_PROBE_EPI_BLOCK moe_epilogue<MODE, MYN>(F, acc, e, slice, tau / PER, chunk_base, nrows, row_off, lane_id(), cp, rg, lane_id() >> 5, false);
#else
#define MOE_PROBE_EPI_BLOCK
#endif
template <int MODE, int MYN>
__device__ __forceinline__ void moe_job_impl(Frame& F, const int e, const int slice, const int chunk_base, const int nrows, const int row_off) {
    constexpr int PER = MODE ? 4 : 32, T = MODE ? 16 : 32;
    constexpr int NST = MODE ? MYN * 4 : MYN * 2;
    const int l = lane_id(), w = F.wave, cp = w & 1, rg = w >> 1, h = l >> 5;
    const bool bwave = w < 4;
    LAS unsigned char* lds = F.lds;
    const unsigned char* abase = MODE ? (const unsigned char*)F.actb : (const unsigned char*)F.h2b;
    const int hl = (w & 3) * 64 + l, cq = hl & 31, kg = hl >> 5;
    const float* bptr; unsigned bld;
    if (MODE == 0) { const int seg = cq >> 4, within = (cq & 15) * 4; bptr = (seg ? F.w_up : F.w_gate) + (size_t)e * D_MODEL * EDIM + (size_t)(kg * 8) * EDIM + 64 * slice + within; bld = EDIM; }
    else { bptr = F.w_down + (size_t)e * EDIM * D_MODEL + (size_t)(kg * 8) * D_MODEL + 512 * slice + cq * 4; bld = D_MODEL; }
#define MOE_ISSUE_B(tau, BR) do { const int _sp = (tau) / PER, _kt = (tau) % PER; const float* _p = bptr + (size_t)_kt * 64 * bld + (MODE ? 128 * _sp : 0); \
        _Pragma("unroll") for (int _j = 0; _j < 8; ++_j) BR[_j] = *(const f32x4*)(_p + (size_t)_j * bld); } while (0)
#define MOE_ISSUE_A(tau, AR) do { const unsigned _k = (unsigned)(((tau) % PER) * 128); \
        _Pragma("unroll") for (int _j = 0; _j < 12; ++_j) AR[_j] = *(const v4u*)(abase + aoff[_j] + _k); } while (0)
    f32x16 acc[3][2];
#pragma unroll
    for (int i = 0; i < 3; ++i)
#pragma unroll
        for (int c = 0; c < 2; ++c)
#pragma unroll
            for (int q = 0; q < 16; ++q) acc[i][c][q] = 0.f;
    __syncthreads();
#define MOE_MFMA(tau) { const int l2 = lane_id(), h2 = l2 >> 5, fsw2 = l2 & 7; \
          const LAS unsigned char* ab = lds + ((tau) & 1) * MOE_ABUF + (unsigned)((rg * 32 + (l2 & 31)) * 128); const LAS unsigned char* bb = lds + ((tau) & 1) * MOE_BBUF + (unsigned)(2 * MOE_ABUF + (cp * 64 + (l2 & 31)) * 128); \
          _Pragma("unroll") for (int s = 0; s < 4; ++s) { const int co = ((2 * s + h2) ^ fsw2) << 4; \
              const bf16x8 w0 = *(const LAS bf16x8*)(bb + co), w1 = *(const LAS bf16x8*)(bb + 32 * 128 + co); \
              _Pragma("unroll") for (int i = 0; i < 3; ++i) if (i < MYN) { const bf16x8 tf = *(const LAS bf16x8*)(ab + i * (4 * 32 * 128) + co); \
                  acc[i][0] = __builtin_amdgcn_mfma_f32_32x32x16_bf16(w0, tf, acc[i][0], 0, 0, 0); \
                  acc[i][1] = __builtin_amdgcn_mfma_f32_32x32x16_bf16(w1, tf, acc[i][1], 0, 0, 0); } } } \
        MOE_PROBE_MFMA_BLOCK \
        if (((tau) % PER) == PER - 1) { MOE_PROBE_EPI_BLOCK moe_epilogue<MODE, MYN>(F, acc, e, slice, (tau) / PER, chunk_base, nrows, row_off, lane_id(), cp, rg, lane_id() >> 5); }
#define MOE_BSTEP(tau_, BR) { const int tau = (tau_); \
        { LAS unsigned char* bbw = lds + 2 * MOE_ABUF + (tau & 1) * MOE_BBUF; \
          const int hl_ = (w & 3) * 64 + lane_id(), cq_ = hl_ & 31, kg = hl_ >> 5; \
          const int ncol0 = MODE ? cq_ * 4 : ((((cq_ & 15) * 4) >> 5) * 2 + (cq_ >> 4)) * 32 + (((cq_ & 15) * 4) & 31); \
          _Pragma("unroll") for (int i = 0; i < 4; ++i) { const int n = ncol0 + i; \
              v4u o; o.x = pg8::cvt_pk_bf16(BR[0][i], BR[1][i]); o.y = pg8::cvt_pk_bf16(BR[2][i], BR[3][i]); o.z = pg8::cvt_pk_bf16(BR[4][i], BR[5][i]); o.w = pg8::cvt_pk_bf16(BR[6][i], BR[7][i]); \
              *(LAS v4u*)(bbw + n * 128 + ((kg ^ (n & 7)) << 4)) = o; } } \
        asm volatile("s_waitcnt lgkmcnt(0)" ::: "memory"); \
        __builtin_amdgcn_s_barrier(); \
        asm volatile("" ::: "memory"); \
        { const int tn = (tau + 3 < T) ? tau + 3 : T - 1; MOE_ISSUE_B(tn, BR); }     \
        asm volatile("" ::: "memory"); \
        MOE_MFMA(tau) }
#define MOE_ASTEP(tau_, AR) { const int tau = (tau_); \
        { LAS unsigned char* abw = lds + (tau & 1) * MOE_ABUF + (w - 4) * 12288; const int l3 = lane_id(); \
          _Pragma("unroll") for (int j = 0; j < 12; ++j) *(LAS v4u*)(abw + j * 1024 + (l3 >> 3) * 128 + (((l3 & 7) ^ ((l3 >> 3) & 7)) << 4)) = AR[j]; } \
        asm volatile("s_waitcnt lgkmcnt(0)" ::: "memory"); \
        __builtin_amdgcn_s_barrier(); \
        asm volatile("" ::: "memory"); \
        { const int tn = (tau + 2 < T) ? tau + 2 : T - 1; MOE_ISSUE_A(tn, AR); } \
        asm volatile("" ::: "memory"); \
        MOE_MFMA(tau) }
    constexpr int TMAIN = T - (T % 3);
    if (bwave) {
        f32x4 breg0[8], breg1[8], breg2[8];
        MOE_ISSUE_B(0, breg0); MOE_ISSUE_B(1, breg1); MOE_ISSUE_B(2, breg2);
        for (int t0 = 0; t0 < TMAIN; t0 += 3) { MOE_BSTEP(t0, breg0) MOE_BSTEP(t0 + 1, breg1) MOE_BSTEP(t0 + 2, breg2) }
        if (T % 3 >= 1) MOE_BSTEP(TMAIN, breg0)
        if (T % 3 == 2) MOE_BSTEP(TMAIN + 1, breg1)
    } else {
        unsigned aoff[12];
#pragma unroll
        for (int j = 0; j < 12; ++j) {
            const int r = ((w - 4) * 12 + j) * 8 + (l >> 3); const int rr = r < nrows ? r : nrows - 1;
            aoff[j] = (MODE == 0 ? (unsigned)(F.lists[e * NTOK + chunk_base + rr] >> 3) * (D_MODEL * 2) : (unsigned)(row_off + chunk_base + rr) * (EDIM * 2)) + (unsigned)((l & 7) << 4);
        }
        v4u areg0[12], areg1[12];
        MOE_ISSUE_A(0, areg0); MOE_ISSUE_A(1, areg1);
        for (int t1 = 0; t1 < T; t1 += 2) { MOE_ASTEP(t1, areg0) MOE_ASTEP(t1 + 1, areg1) }
    }
    MOE_WAITV(0);
#undef MOE_BSTEP
#undef MOE_ASTEP
#undef MOE_MFMA
#undef MOE_ISSUE_A
#undef MOE_ISSUE_B
}
template <int MODE>
__device__ __forceinline__ void moe_job(Frame& F, const int e, const int slice, const int chunk_base, const int nrows, const int row_off) {
    const int rg = F.wave >> 1, nrb = (nrows + 31) >> 5;
    const int my_n = (nrb > rg) ? ((nrb - rg + 3) >> 2) : 0;
    if (my_n == 3) moe_job_impl<MODE, 3>(F, e, slice, chunk_base, nrows, row_off);
    else if (my_n == 2) moe_job_impl<MODE, 2>(F, e, slice, chunk_base, nrows, row_off);
    else if (my_n == 1) moe_job_impl<MODE, 1>(F, e, slice, chunk_base, nrows, row_off);
    else moe_job_impl<MODE, 0>(F, e, slice, chunk_base, nrows, row_off);
}
template <int MODE>
__device__ __forceinline__ void moe_stage(Frame& F, const int rep = 0) {
    moe_tables(F);
    const LAS int* cnt = (const LAS int*)(F.lds + MOE_TAB); const LAS int* order = cnt + 256; const LAS int* offs = order + 256; const LAS int* pre = offs + 256;
    volatile LAS int* qslot = (volatile LAS int*)(pre + 260 + 264);
    const int nitems = pre[256] * 4;
    for (;;) {
        __syncthreads();
        if (F.wave == 0 && lane_id() == 0) qslot[0] = (int)__hip_atomic_fetch_add(F.ctl + CW_QHEAD + 64 * (MODE + 2 * rep), 1u, __ATOMIC_RELAXED, __HIP_MEMORY_SCOPE_AGENT);
        __syncthreads();
        const int it = qslot[0];
        if (it >= nitems) break;
        const int g = it >> 2, slice = it & 3;
        int lo = 0, hi = 255;
        while (lo < hi) { const int mid = (lo + hi + 1) >> 1; if (pre[mid] <= g) lo = mid; else hi = mid - 1; }
        const int e = order[lo], n = cnt[e], cb = (g - pre[lo]) * MOE_MC;
        moe_job<MODE>(F, e, slice, cb, (n - cb) < MOE_MC ? (n - cb) : MOE_MC, offs[e]);
    }
    __syncthreads();
}

typedef short s16x4 __attribute__((ext_vector_type(4)));
#define MFMA32(a, b, c) __builtin_amdgcn_mfma_f32_32x32x16_bf16((a), (b), (c), 0, 0, 0)
__device__ __forceinline__ void ph_attn(Frame& F) {
    const int l = lane_id(), w = F.wave, hh = l >> 5, r = l & 31;
    LAS float* biasl = (LAS float*)(F.lds + 81920);
    LAS unsigned char* Vl = F.lds + w * 10240;
    const float LOG2E = 1.4426950408889634f;
    for (int g = blockIdx.x; g < 256; g += gridDim.x) {
        const int bh = g >> 4, b = bh >> 3, h = bh & 7;
        __syncthreads();
        for (int i = (F.wave * 64 + lane_id()); i < 320; i += 512) biasl[i] = F.rel_bias[h * 320 + i] * LOG2E;
        __syncthreads();
        const int c = (g & 15) * 4 + (w >> 1), qh = w & 1;
        const int qrow = c * 64 + qh * 32 + r;
        const bf16* qp = F.projb + (size_t)(b * SEQ + qrow) * IN_WIDTH + h * 128 + 8 * hh;
        bf16x8 qf[8];
#pragma unroll
        for (int s = 0; s < 8; ++s) qf[s] = *(const bf16x8*)(qp + 16 * s);
        f32x16 o[4];
#pragma unroll
        for (int d = 0; d < 4; ++d)
#pragma unroll
            for (int q = 0; q < 16; ++q) o[d][q] = 0.f;
        float m = -1e30f, lsum = 0.f;
        const int kstart = c >= 8 ? (c - 8) * 64 : 0; const int nblk = (c * 64 + 64 - kstart) >> 5;
        const float sscale = 0.08838834764831845f * LOG2E;
        for (int jb = 0; jb < nblk; ++jb) {
            const int kb = kstart + jb * 32;
            const bf16* kp = F.projb + (size_t)(b * SEQ + kb + r) * IN_WIDTH + 1024 + h * 128 + 8 * hh;
            bf16x8 kf[8];
#pragma unroll
            for (int s = 0; s < 8; ++s) kf[s] = *(const bf16x8*)(kp + 16 * s);
            const bf16* vp = F.projb + (size_t)(b * SEQ + kb + (l >> 4)) * IN_WIDTH + 2048 + h * 128 + (l & 15) * 8;
            v4u vr[8];
#pragma unroll
            for (int i = 0; i < 8; ++i) vr[i] = *(const v4u*)(vp + (size_t)i * 4 * IN_WIDTH);
            f32x16 sacc;
#pragma unroll
            for (int q = 0; q < 16; ++q) sacc[q] = 0.f;
#pragma unroll
            for (int s = 0; s < 8; ++s) sacc = MFMA32(kf[s], qf[s], sacc);
#pragma unroll
            for (int i = 0; i < 8; ++i) *(LAS v4u*)(Vl + (4 * i + (l >> 4)) * 320 + (l & 15) * 16) = vr[i];
            float sc[16]; float mx = -1e30f;
#pragma unroll
            for (int q = 0; q < 16; ++q) {
                const int key = (q & 3) + 8 * (q >> 2) + 4 * hh;
                int idx = qrow - (kb + key) + 63; idx = idx > 319 ? 319 : idx;
                sc[q] = sacc[q] * sscale + biasl[idx]; mx = fmaxf(mx, sc[q]);
            }
            mx = fmaxf(mx, __shfl_xor(mx, 32));
            const float mnew = fmaxf(m, mx); const float alpha = __builtin_amdgcn_exp2f(m - mnew); m = mnew;
            float ps = 0.f;
#pragma unroll
            for (int q = 0; q < 16; ++q) { sc[q] = __builtin_amdgcn_exp2f(sc[q] - mnew); ps += sc[q]; }
            lsum = lsum * alpha + ps;
            if (__any(alpha != 1.0f)) {
#pragma unroll
                for (int d = 0; d < 4; ++d) o[d] *= alpha;
            }
            bf16x8 pf[2];
#pragma unroll
            for (int s2 = 0; s2 < 2; ++s2) {
                v4u pk; pk.x = pg8::cvt_pk_bf16(sc[8 * s2 + 0], sc[8 * s2 + 1]); pk.y = pg8::cvt_pk_bf16(sc[8 * s2 + 2], sc[8 * s2 + 3]);
                pk.z = pg8::cvt_pk_bf16(sc[8 * s2 + 4], sc[8 * s2 + 5]); pk.w = pg8::cvt_pk_bf16(sc[8 * s2 + 6], sc[8 * s2 + 7]);
                pf[s2] = __builtin_bit_cast(bf16x8, pk);
            }
            const LAS unsigned char* vt = Vl + (4 * hh + ((l & 15) >> 2)) * 320 + (((l >> 4) & 1) * 16 + 4 * (l & 3)) * 2;
#pragma unroll
            for (int s2 = 0; s2 < 2; ++s2)
#pragma unroll
                for (int db = 0; db < 4; ++db) {
                    const s16x4 t0 = __builtin_amdgcn_ds_read_tr16_b64_v4i16((LAS s16x4*)(vt + (16 * s2) * 320 + db * 64));
                    const s16x4 t1 = __builtin_amdgcn_ds_read_tr16_b64_v4i16((LAS s16x4*)(vt + (16 * s2 + 8) * 320 + db * 64));
                    bf16x8 vf; vf[0] = t0[0]; vf[1] = t0[1]; vf[2] = t0[2]; vf[3] = t0[3]; vf[4] = t1[0]; vf[5] = t1[1]; vf[6] = t1[2]; vf[7] = t1[3];
                    o[db] = MFMA32(vf, pf[s2], o[db]);
                }
        }
        lsum += __shfl_xor(lsum, 32);
        const float inv = 1.0f / lsum;
        const size_t tok = (size_t)b * SEQ + qrow;
        float ssq = 0.f;
#pragma unroll
        for (int db = 0; db < 4; ++db)
#pragma unroll
            for (int gq = 0; gq < 4; ++gq) {
                const int col = h * 128 + db * 32 + 8 * gq + 4 * hh;
                const f32x4 gn = *(const f32x4*)(F.attn_gain + col);
                float v[4];
#pragma unroll
                for (int j = 0; j < 4; ++j) { v[j] = o[db][4 * gq + j] * inv; ssq += v[j] * v[j]; }
                uint2 ov; ov.x = pg8::cvt_pk_bf16(v[0] * gn[0], v[1] * gn[1]); ov.y = pg8::cvt_pk_bf16(v[2] * gn[2], v[3] * gn[3]);
                *(uint2*)(F.ycatb + tok * D_MODEL + col) = ov;
            }
        ssq += __shfl_xor(ssq, 32);
        if (hh == 0) F.ssq[tok * 8 + h] = ssq;
    }
    __syncthreads();
}

__device__ __forceinline__ float lg2_gamma(int h) { return log2f(1.0f - exp2f(-5.0f - (float)h)); }
__device__ __forceinline__ void ph_rot2(Frame& F) {
    const int gt = (int)blockIdx.x * 512 + (F.wave * 64 + lane_id()), GT = (int)gridDim.x * 512;
    for (int i = gt; i < NTOK * 32; i += GT) {
        const int g = i & 3, h = (i >> 2) & 7, t = i >> 5, s = t % SEQ;
        const bf16* pq = F.projb + (size_t)t * IN_WIDTH + 3072 + h * 64 + 8 * g; const bf16* pk = pq + 512;
        const v4u q1 = *(const v4u*)pq, q2 = *(const v4u*)(pq + 32), k1 = *(const v4u*)pk, k2 = *(const v4u*)(pk + 32);
        const float* csp = F.cs + ((size_t)s * 32 + 8 * g) * 2;
        v4u oq1, oq2, ok1, ok2;
#pragma unroll
        for (int j = 0; j < 4; ++j) {
            const f32x4 c4 = *(const f32x4*)(csp + 4 * j);
            const unsigned a = q1[j], bq = q2[j], ka = k1[j], kb = k2[j];
            const float q1l = bf2f((unsigned short)(a & 0xffff)), q1h = bf2f((unsigned short)(a >> 16)), q2l = bf2f((unsigned short)(bq & 0xffff)), q2h = bf2f((unsigned short)(bq >> 16));
            const float k1l = bf2f((unsigned short)(ka & 0xffff)), k1h = bf2f((unsigned short)(ka >> 16)), k2l = bf2f((unsigned short)(kb & 0xffff)), k2h = bf2f((unsigned short)(kb >> 16));
            oq1[j] = pk2(q1l * c4[0] - q2l * c4[1], q1h * c4[2] - q2h * c4[3]); oq2[j] = pk2(q2l * c4[0] + q1l * c4[1], q2h * c4[2] + q1h * c4[3]);
            ok1[j] = pk2((k1l * c4[0] - k2l * c4[1]) * 0.125f, (k1h * c4[2] - k2h * c4[3]) * 0.125f); ok2[j] = pk2((k2l * c4[0] + k1l * c4[1]) * 0.125f, (k2h * c4[2] + k1h * c4[3]) * 0.125f);
        }
        bf16* dq = F.qrb + (size_t)t * 512 + h * 64 + 8 * g; bf16* dk = F.krb + (size_t)t * 512 + h * 64 + 8 * g;
        *(v4u*)dq = oq1; *(v4u*)(dq + 32) = oq2; *(v4u*)dk = ok1; *(v4u*)(dk + 32) = ok2;
    }
}
__device__ __forceinline__ void ret_stage_v(Frame& F, LAS unsigned char* Vt, size_t tok0, int h, int pl) {
    const bf16* vp = F.projb + (tok0 + (pl >> 4)) * IN_WIDTH + 4096 + h * 128 + (pl & 15) * 8;
    v4u vr[8];
#pragma unroll
    for (int i = 0; i < 8; ++i) vr[i] = *(const v4u*)(vp + (size_t)i * 8 * IN_WIDTH);
#pragma unroll
    for (int i = 0; i < 8; ++i) *(LAS v4u*)(Vt + (i * 8 + (pl >> 4)) * 320 + (pl & 15) * 16) = vr[i];
}
__device__ __forceinline__ bf16x8 tr_pair(const LAS unsigned char* p, int rowbytes4) {
    const s16x4 t0 = __builtin_amdgcn_ds_read_tr16_b64_v4i16((LAS s16x4*)p);
    const s16x4 t1 = __builtin_amdgcn_ds_read_tr16_b64_v4i16((LAS s16x4*)(p + rowbytes4));
    bf16x8 v; v[0] = t0[0]; v[1] = t0[1]; v[2] = t0[2]; v[3] = t0[3]; v[4] = t1[0]; v[5] = t1[1]; v[6] = t1[2]; v[7] = t1[3]; return v;
}
__device__ __forceinline__ void ph_ret_a(Frame& F) {
    const int l = lane_id(), w = F.wave, hh = l >> 5, r = l & 31, cpair = w >> 1, vh = w & 1, pl = vh * 64 + l;
    LAS unsigned char* Vt = F.lds + cpair * 32768; LAS unsigned char* Kt = Vt + 20480;
    for (int g = blockIdx.x; g < 256; g += gridDim.x) {
        const int bh = g >> 4, b = bh >> 3, h = bh & 7, c = (g & 15) * 4 + cpair;
        const size_t tok0 = (size_t)b * SEQ + c * 64;
        const float lg2 = lg2_gamma(h);
        __syncthreads();
        ret_stage_v(F, Vt, tok0, h, pl);
        {
            const bf16* kp = F.krb + (tok0 + (pl >> 3)) * 512 + h * 64 + (pl & 7) * 8;
#pragma unroll
            for (int i = 0; i < 4; ++i) {
                const int row = i * 16 + (pl >> 3);
                const v4u kv = *(const v4u*)(kp + (size_t)i * 16 * 512);
                const float z = __builtin_amdgcn_exp2f(lg2 * (float)(63 - row));
                v4u o;
#pragma unroll
                for (int j = 0; j < 4; ++j) o[j] = pk2(bf2f((unsigned short)(kv[j] & 0xffff)) * z, bf2f((unsigned short)(kv[j] >> 16)) * z);
                *(LAS v4u*)(Kt + row * 192 + (pl & 7) * 16) = o;
            }
        }
        __syncthreads();
        f32x16 acc[2][2];
#pragma unroll
        for (int a = 0; a < 2; ++a)
#pragma unroll
            for (int bq = 0; bq < 2; ++bq)
#pragma unroll
                for (int q = 0; q < 16; ++q) acc[a][bq][q] = 0.f;
        const int q4 = (l & 15) >> 2, p4 = l & 3, ch = (l >> 4) & 1;
#pragma unroll
        for (int s = 0; s < 4; ++s) {
            bf16x8 vf[2], kf[2];
#pragma unroll
            for (int a = 0; a < 2; ++a) vf[a] = tr_pair(Vt + (16 * s + 8 * hh + q4) * 320 + ((2 * vh + a) * 32 + ch * 16 + 4 * p4) * 2, 4 * 320);
#pragma unroll
            for (int bq = 0; bq < 2; ++bq) kf[bq] = tr_pair(Kt + (16 * s + 8 * hh + q4) * 192 + (bq * 32 + ch * 16 + 4 * p4) * 2, 4 * 192);
#pragma unroll
            for (int a = 0; a < 2; ++a)
#pragma unroll
                for (int bq = 0; bq < 2; ++bq) acc[a][bq] = MFMA32(vf[a], kf[bq], acc[a][bq]);
        }
        float* ut = F.UT + ((size_t)bh * 64 + c) * 8192;
#pragma unroll
        for (int a = 0; a < 2; ++a)
#pragma unroll
            for (int bq = 0; bq < 2; ++bq)
#pragma unroll
                for (int q = 0; q < 16; ++q) {
                    const int v = (2 * vh + a) * 32 + (q & 3) + 8 * (q >> 2) + 4 * hh;
                    ut[v * 64 + bq * 32 + r] = acc[a][bq][q];
                }
    }
    __syncthreads();
}
__device__ __forceinline__ void ph_ret_scan2(Frame& F) {
    const int gt = (int)blockIdx.x * 512 + (F.wave * 64 + lane_id()), GT = (int)gridDim.x * 512;
    for (int i = gt; i < 2 * 8 * 8192; i += GT) {
        const int e = i & 8191, bh = i >> 13, h = bh & 7;
        const float g = __builtin_amdgcn_exp2f(lg2_gamma(h) * 64.0f);
        float st = 0.f;
        const float* up = F.UT + (size_t)bh * 64 * 8192 + e; bf16* rp = F.RT + (size_t)bh * 64 * 8192 + e;
#pragma unroll 8
        for (int c = 0; c < 64; ++c) { rp[(size_t)c * 8192] = (bf16)f2bf(st); st = g * st + up[(size_t)c * 8192]; }
    }
}
__device__ __forceinline__ void ph_ret_b(Frame& F) {
    const int l = lane_id(), w = F.wave, hh = l >> 5, r = l & 31, cpair = w >> 1, nh = w & 1, pl = nh * 64 + l;
    LAS unsigned char* Vt = F.lds + cpair * 20480;
    for (int g = blockIdx.x; g < 256; g += gridDim.x) {
        const int bh = g >> 4, b = bh >> 3, h = bh & 7, c = (g & 15) * 4 + cpair;
        const size_t tok0 = (size_t)b * SEQ + c * 64;
        const float lg2 = lg2_gamma(h);
        __syncthreads();
        ret_stage_v(F, Vt, tok0, h, pl);
        const int n = nh * 32 + r;
        bf16x8 qf[4], kf[2][4];
        const bf16* qp = F.qrb + (tok0 + n) * 512 + h * 64 + 8 * hh;
#pragma unroll
        for (int s = 0; s < 4; ++s) qf[s] = *(const bf16x8*)(qp + 16 * s);
#pragma unroll
        for (int mb = 0; mb < 2; ++mb) { const bf16* kp = F.krb + (tok0 + mb * 32 + r) * 512 + h * 64 + 8 * hh;
#pragma unroll
            for (int s = 0; s < 4; ++s) kf[mb][s] = *(const bf16x8*)(kp + 16 * s); }
        f32x16 sacc[2];
#pragma unroll
        for (int mb = 0; mb < 2; ++mb) {
#pragma unroll
            for (int q = 0; q < 16; ++q) sacc[mb][q] = 0.f;
#pragma unroll
            for (int s = 0; s < 4; ++s) sacc[mb] = MFMA32(kf[mb][s], qf[s], sacc[mb]);
        }
        bf16x8 pf[2][2];
#pragma unroll
        for (int mb = 0; mb < 2; ++mb) {
            float p[16];
#pragma unroll
            for (int q = 0; q < 16; ++q) { const int m = mb * 32 + (q & 3) + 8 * (q >> 2) + 4 * hh; const int dd = n > m ? n - m : m - n; p[q] = sacc[mb][q] * __builtin_amdgcn_exp2f(lg2 * (float)dd); }
#pragma unroll
            for (int s2 = 0; s2 < 2; ++s2) { v4u pk; pk.x = pg8::cvt_pk_bf16(p[8 * s2], p[8 * s2 + 1]); pk.y = pg8::cvt_pk_bf16(p[8 * s2 + 2], p[8 * s2 + 3]); pk.z = pg8::cvt_pk_bf16(p[8 * s2 + 4], p[8 * s2 + 5]); pk.w = pg8::cvt_pk_bf16(p[8 * s2 + 6], p[8 * s2 + 7]); pf[mb][s2] = __builtin_bit_cast(bf16x8, pk); }
        }
        const float xi = __builtin_amdgcn_exp2f(lg2 * (float)(n + 1));
        bf16x8 qx[4];
#pragma unroll
        for (int s = 0; s < 4; ++s) { const v4u qv = __builtin_bit_cast(v4u, qf[s]); v4u o;
#pragma unroll
            for (int j = 0; j < 4; ++j) o[j] = pk2(bf2f((unsigned short)(qv[j] & 0xffff)) * xi, bf2f((unsigned short)(qv[j] >> 16)) * xi);
            qx[s] = __builtin_bit_cast(bf16x8, o); }
        f32x16 o[4];
#pragma unroll
        for (int vb = 0; vb < 4; ++vb)
#pragma unroll
            for (int q = 0; q < 16; ++q) o[vb][q] = 0.f;
        const bf16* rt = F.RT + ((size_t)bh * 64 + c) * 8192 + 8 * hh;
#pragma unroll
        for (int vb = 0; vb < 4; ++vb) {
            bf16x8 rf[4];
#pragma unroll
            for (int s = 0; s < 4; ++s) rf[s] = *(const bf16x8*)(rt + (size_t)(vb * 32 + r) * 64 + 16 * s);
#pragma unroll
            for (int s = 0; s < 4; ++s) o[vb] = MFMA32(rf[s], qx[s], o[vb]);
        }
        __syncthreads();
        const LAS unsigned char* vt = Vt + (4 * hh + ((l & 15) >> 2)) * 320 + (((l >> 4) & 1) * 16 + 4 * (l & 3)) * 2;
#pragma unroll
        for (int mb = 0; mb < 2; ++mb)
#pragma unroll
            for (int s2 = 0; s2 < 2; ++s2)
#pragma unroll
                for (int vb = 0; vb < 4; ++vb) {
                    const bf16x8 vf = tr_pair(vt + (mb * 32 + 16 * s2) * 320 + vb * 64, 8 * 320);
                    o[vb] = MFMA32(vf, pf[mb][s2], o[vb]);
                }
        float s1 = 0.f;
#pragma unroll
        for (int vb = 0; vb < 4; ++vb)
#pragma unroll
            for (int q = 0; q < 16; ++q) s1 += o[vb][q];
        s1 += __shfl_xor(s1, 32);
        const float mu = s1 * (1.0f / 128.0f); float s2v = 0.f;
#pragma unroll
        for (int vb = 0; vb < 4; ++vb)
#pragma unroll
            for (int q = 0; q < 16; ++q) { const float d = o[vb][q] - mu; s2v += d * d; }
        s2v += __shfl_xor(s2v, 32);
        const float rs = rsqrtf(s2v * (1.0f / 128.0f) + EPS_F);
        const size_t tok = tok0 + n;
#pragma unroll
        for (int vb = 0; vb < 4; ++vb)
#pragma unroll
            for (int gq = 0; gq < 4; ++gq) {
                const int col = h * 128 + vb * 32 + 8 * gq + 4 * hh;
                const uint2 gbv = *(const uint2*)(F.projb + tok * IN_WIDTH + 5120 + col);
                const f32x4 gn = *(const f32x4*)(F.ret_gain + col);
                const float g0 = bf2f((unsigned short)(gbv.x & 0xffff)), g1 = bf2f((unsigned short)(gbv.x >> 16)), g2 = bf2f((unsigned short)(gbv.y & 0xffff)), g3 = bf2f((unsigned short)(gbv.y >> 16));
                uint2 ov;
                ov.x = pg8::cvt_pk_bf16(silu_f(g0) * (o[vb][4 * gq] - mu) * rs * gn[0], silu_f(g1) * (o[vb][4 * gq + 1] - mu) * rs * gn[1]);
                ov.y = pg8::cvt_pk_bf16(silu_f(g2) * (o[vb][4 * gq + 2] - mu) * rs * gn[2], silu_f(g3) * (o[vb][4 * gq + 3] - mu) * rs * gn[3]);
                *(uint2*)(F.ycatb + tok * D_MODEL + 1024 + col) = ov;
            }
    }
    __syncthreads();
}

__device__ __forceinline__ void ph_route2(Frame& F) {
    const int l = lane_id(), gw = (int)blockIdx.x * 8 + F.wave, GW = (int)gridDim.x * 8;
    const f32x4 rb = *(const f32x4*)(F.router_bias + 4 * l);
    for (int t = gw; t < NTOK; t += GW) {
        const f32x4 lg = *(const f32x4*)(F.rsg + (size_t)t * 768 + 4 * l);
        float s[4], bsc[4];
#pragma unroll
        for (int i = 0; i < 4; ++i) { s[i] = sigmoid_f(lg[i]); bsc[i] = s[i] + rb[i]; }
        float m1 = fmaxf(bsc[0], bsc[1]), m2 = fminf(bsc[0], bsc[1]);
        { const float a1 = fmaxf(bsc[2], bsc[3]), a2 = fminf(bsc[2], bsc[3]); const float n1 = fmaxf(m1, a1), n2 = fmaxf(fminf(m1, a1), fmaxf(m2, a2)); m1 = n1; m2 = n2; }
#pragma unroll
        for (int o = 1; o < 8; o <<= 1) { const float a1 = __shfl_xor(m1, o), a2 = __shfl_xor(m2, o); const float n1 = fmaxf(m1, a1), n2 = fmaxf(fminf(m1, a1), fmaxf(m2, a2)); m1 = n1; m2 = n2; }
        const float gs = m1 + m2; const int grp = l >> 3;
        int rank = 0;
#pragma unroll
        for (int g = 0; g < 8; ++g) { const float og = __shfl(gs, 8 * g); rank += (og > gs || (og == gs && g < grp)) ? 1 : 0; }
        const bool sel = rank < 4;
        float mv[4];
#pragma unroll
        for (int i = 0; i < 4; ++i) mv[i] = sel ? bsc[i] : -1e30f;
        float wsum = 0.f; int myidx = 0; float mysc = 0.f;
#pragma unroll
        for (int rr = 0; rr < 8; ++rr) {
            float bv = mv[0]; int bi = 4 * l; float bs = s[0];
#pragma unroll
            for (int i = 1; i < 4; ++i) if (mv[i] > bv) { bv = mv[i]; bi = 4 * l + i; bs = s[i]; }
#pragma unroll
            for (int o = 1; o < 64; o <<= 1) {
                const float ov = __shfl_xor(bv, o); const int oi = __shfl_xor(bi, o); const float os = __shfl_xor(bs, o);
                if (ov > bv || (ov == bv && oi < bi)) { bv = ov; bi = oi; bs = os; }
            }
            wsum += bs;
            if (l == rr) { myidx = bi; mysc = bs; }
#pragma unroll
            for (int i = 0; i < 4; ++i) if (bi == 4 * l + i) mv[i] = -3e30f;
        }
        if (l < 8) {
            const int slot = atomicAdd(&F.counts[myidx], 1);
            F.lists[myidx * NTOK + slot] = t * 8 + l; F.a_w[t * 8 + l] = mysc / wsum * 2.5f;
        }
    }
}
__device__ __forceinline__ void ph_swiglu2(Frame& F) {
    const size_t gt = (size_t)blockIdx.x * 512 + (F.wave * 64 + lane_id()), GT = (size_t)gridDim.x * 512;
    for (size_t i = gt; i < (size_t)NTOK * 64; i += GT) { const size_t t = i >> 6; const int j = (int)(i & 63) * 4;
        const f32x4 ga = *(const f32x4*)(F.rsg + t * 768 + 256 + j), up = *(const f32x4*)(F.rsg + t * 768 + 512 + j);
        uint2 o; o.x = pk2(silu_f(ga[0]) * up[0], silu_f(ga[1]) * up[1]); o.y = pk2(silu_f(ga[2]) * up[2], silu_f(ga[3]) * up[3]);
        *(uint2*)(F.sactb + t * 256 + j) = o; }
}
template <bool XRES_BF16, bool HAS_CONTRIB>
__device__ __forceinline__ void ph_res_ln2(Frame& F, const void* __restrict__ xres_, const float* __restrict__ y, const bf16* __restrict__ contrib, int g_off,
                                           const float* __restrict__ gain, const float* __restrict__ bias, float* __restrict__ xo_f32, bf16* __restrict__ xo_bf16, int sh_off, int sc_off, bf16* __restrict__ hmod) {
    const int gw = (int)blockIdx.x * 8 + F.wave, GW = (int)gridDim.x * 8;
    for (int t = gw; t < NTOK; t += GW) {
        const unsigned lo = 8u * (unsigned)lane_id();
        const int b = t / SEQ; const float* mb = F.mod + b * 6 * D_MODEL;
        const float* yrow = y + (size_t)t * D_MODEL;
        const bf16* crow = contrib + (size_t)t * 8 * D_MODEL;
        const bf16* xrb = (const bf16*)xres_ + (size_t)t * D_MODEL; const float* xrf = (const float*)xres_ + (size_t)t * D_MODEL;
        float z[32]; float s = 0.f;
#pragma unroll
        for (int j = 0; j < 4; ++j) {
            const unsigned d = lo + 512u * j;
            asm volatile("" ::: "memory");
            float yy[8];
            { const f32x4 a = *(const f32x4*)(yrow + d), c = *(const f32x4*)(yrow + d + 4); yy[0] = a[0]; yy[1] = a[1]; yy[2] = a[2]; yy[3] = a[3]; yy[4] = c[0]; yy[5] = c[1]; yy[6] = c[2]; yy[7] = c[3]; }
            if (HAS_CONTRIB) {
#pragma unroll
                for (int k = 0; k < 8; ++k) { const v4u cv = *(const v4u*)(crow + (unsigned)(k * D_MODEL) + d);
#pragma unroll
                    for (int q = 0; q < 4; ++q) { yy[2 * q] += bf2f((unsigned short)(cv[q] & 0xffff)); yy[2 * q + 1] += bf2f((unsigned short)(cv[q] >> 16)); } }
            }
            float xr[8];
            if (XRES_BF16) { const v4u xv = *(const v4u*)(xrb + d);
#pragma unroll
                for (int q = 0; q < 4; ++q) { xr[2 * q] = bf2f((unsigned short)(xv[q] & 0xffff)); xr[2 * q + 1] = bf2f((unsigned short)(xv[q] >> 16)); } }
            else { const f32x4 a = *(const f32x4*)(xrf + d), c = *(const f32x4*)(xrf + d + 4); xr[0] = a[0]; xr[1] = a[1]; xr[2] = a[2]; xr[3] = a[3]; xr[4] = c[0]; xr[5] = c[1]; xr[6] = c[2]; xr[7] = c[3]; }
            const f32x4 g0 = *(const f32x4*)(mb + g_off + d), g1 = *(const f32x4*)(mb + g_off + d + 4);
#pragma unroll
            for (int q = 0; q < 8; ++q) { const float gg = q < 4 ? g0[q & 3] : g1[q & 3]; z[8 * j + q] = ALPHA_F * xr[q] + gg * yy[q]; s += z[8 * j + q]; }
        }
        s = wave_sum(s);
        const float mu = s * (1.0f / D_MODEL); float qv = 0.f;
#pragma unroll
        for (int j = 0; j < 32; ++j) { const float dv = z[j] - mu; qv += dv * dv; }
        qv = wave_sum(qv);
        const float rs = rsqrtf(qv * (1.0f / D_MODEL) + EPS_F);
        float* of = xo_f32 + (size_t)t * D_MODEL; bf16* ob = xo_bf16 + (size_t)t * D_MODEL; bf16* oh = hmod + (size_t)t * D_MODEL;
        const unsigned lo2 = 8u * (unsigned)lane_id();
#pragma unroll
        for (int j = 0; j < 4; ++j) {
            const unsigned d = lo2 + 512u * j;
            asm volatile("" ::: "memory");
            const f32x4 ga = *(const f32x4*)(gain + d), gb = *(const f32x4*)(gain + d + 4), ba = *(const f32x4*)(bias + d), bb = *(const f32x4*)(bias + d + 4);
            float v[8];
#pragma unroll
            for (int q = 0; q < 8; ++q) v[q] = (z[8 * j + q] - mu) * rs * (q < 4 ? ga[q & 3] : gb[q & 3]) + (q < 4 ? ba[q & 3] : bb[q & 3]);
            if (xo_f32) { *(f32x4*)(of + d) = (f32x4){v[0], v[1], v[2], v[3]}; *(f32x4*)(of + d + 4) = (f32x4){v[4], v[5], v[6], v[7]}; }
            if (xo_bf16) { v4u w; w.x = pk2(v[0], v[1]); w.y = pk2(v[2], v[3]); w.z = pk2(v[4], v[5]); w.w = pk2(v[6], v[7]); *(v4u*)(ob + d) = w; }
            if (hmod) {
                const f32x4 c0 = *(const f32x4*)(mb + sc_off + d), c1 = *(const f32x4*)(mb + sc_off + d + 4), h0 = *(const f32x4*)(mb + sh_off + d), h1 = *(const f32x4*)(mb + sh_off + d + 4);
                float hv[8];
#pragma unroll
                for (int q = 0; q < 8; ++q) hv[q] = v[q] * (1.0f + (q < 4 ? c0[q & 3] : c1[q & 3])) + (q < 4 ? h0[q & 3] : h1[q & 3]);
                v4u w; w.x = pk2(hv[0], hv[1]); w.y = pk2(hv[2], hv[3]); w.z = pk2(hv[4], hv[5]); w.w = pk2(hv[6], hv[7]); *(v4u*)(oh + d) = w;
            }
        }
    }
}

struct Args { const float* in[21]; float* out; unsigned char* ws; int ph_lo, ph_hi, li, pad; };
constexpr size_t WS_CTL_BYTES = 65536;

__global__ void __launch_bounds__(512, 2) mk_fwd(Args a) {
    extern __shared__ __attribute__((aligned(16))) unsigned char lds_raw[];
    Frame F;
    F.lds = (LAS unsigned char*)lds_raw;
    F.nvb = gridDim.x * 2;
    F.wave = __builtin_amdgcn_readfirstlane((int)threadIdx.x >> 6); F.G = gridDim.x;
    { const int bx = blockIdx.x; F.vcu = (F.G % 8 == 0) ? (bx % 8) * (F.G / 8) + bx / 8 : bx; }
    F.ctl = (unsigned*)a.ws;
    F.x = a.in[0]; F.c = a.in[1]; F.w_ada = a.in[2]; F.b_ada = a.in[3]; F.w_in = a.in[4]; F.rel_bias = a.in[5]; F.attn_gain = a.in[6]; F.ret_gain = a.in[7]; F.w_out = a.in[8];
    F.ln1_g = a.in[9]; F.ln1_b = a.in[10]; F.w_router = a.in[11]; F.router_bias = a.in[12]; F.w_gate = a.in[13]; F.w_up = a.in[14]; F.w_down = a.in[15]; F.ws_gate = a.in[16];
    F.ws_up = a.in[17]; F.ws_down = a.in[18]; F.ln2_g = a.in[19]; F.ln2_b = a.in[20]; F.out = a.out;
    {
        unsigned char* w = a.ws; size_t off = WS_CTL_BYTES;
#define CARVE(T, name, bytes) name = (T*)(w + off); off += (((size_t)(bytes)) + 255) & ~(size_t)255
        F.counts = (int*)(w + 61440);
        CARVE(float, F.mod, 2 * 6 * D_MODEL * 4); CARVE(float, F.cs, SEQ * 32 * 2 * 4); CARVE(float, F.h1, (size_t)NTOK * D_MODEL * 4); CARVE(float, F.proj, (size_t)NTOK * IN_WIDTH * 4);
        CARVE(float, F.qr, (size_t)NTOK * 512 * 4); CARVE(float, F.kr, (size_t)NTOK * 512 * 4); CARVE(float, F.attn_out, (size_t)NTOK * 1024 * 4);
        CARVE(float, F.U, (size_t)2 * 8 * 64 * 8192 * 4); CARVE(float, F.R, (size_t)2 * 8 * 64 * 8192 * 4); CARVE(float, F.ycat, (size_t)NTOK * D_MODEL * 4);
        CARVE(float, F.mixer, (size_t)NTOK * D_MODEL * 4); CARVE(float, F.x1, (size_t)NTOK * D_MODEL * 4); CARVE(float, F.h2, (size_t)NTOK * D_MODEL * 4);
        CARVE(float, F.logits, (size_t)NTOK * NEXP * 4); CARVE(int, F.lists, (size_t)NEXP * NTOK * 4); CARVE(int, F.a_exp, (size_t)NTOK * 8 * 4); CARVE(float, F.a_w, (size_t)NTOK * 8 * 4);
        CARVE(float, F.act, (size_t)NTOK * 8 * EDIM * 4); CARVE(float, F.contrib, (size_t)NTOK * 8 * D_MODEL * 4); CARVE(float, F.sgu, (size_t)NTOK * 512 * 4);
        CARVE(float, F.sact, (size_t)NTOK * 256 * 4); CARVE(float, F.sh_out, (size_t)NTOK * D_MODEL * 4);
        CARVE(float, F.modp, (size_t)16 * 2 * 6 * D_MODEL * 4); CARVE(bf16, F.w_in_t, (size_t)IN_WIDTH * D_MODEL * 2); CARVE(bf16, F.h1b, (size_t)NTOK * D_MODEL * 2);
        CARVE(bf16, F.w_out_t, (size_t)D_MODEL * D_MODEL * 2); CARVE(bf16, F.wr_t, (size_t)768 * D_MODEL * 2); CARVE(bf16, F.ws_down_t, (size_t)D_MODEL * 256 * 2);
        CARVE(bf16, F.ycatb, (size_t)NTOK * D_MODEL * 2); CARVE(bf16, F.h2b, (size_t)NTOK * D_MODEL * 2); CARVE(bf16, F.sactb, (size_t)NTOK * 256 * 2); CARVE(float, F.rsg, (size_t)NTOK * 768 * 4);
        CARVE(bf16, F.actb, (size_t)(NTOK * 8 + 512) * EDIM * 2); CARVE(bf16, F.contribb, (size_t)NTOK * 8 * D_MODEL * 2);
        CARVE(bf16, F.projb, (size_t)NTOK * IN_WIDTH * 2); CARVE(float, F.ssq, (size_t)NTOK * 8 * 4);
        CARVE(bf16, F.qrb, (size_t)NTOK * 512 * 2); CARVE(bf16, F.krb, (size_t)NTOK * 512 * 2); CARVE(float, F.UT, (size_t)16 * 64 * 8192 * 4); CARVE(bf16, F.RT, (size_t)16 * 64 * 8192 * 2); CARVE(bf16, F.x1b, (size_t)NTOK * D_MODEL * 2);
#undef CARVE
    }
    for (int u = (F.wave * 64 + lane_id()); u < (LDS_BYTES - 131072) / 4; u += 512) ((LAS unsigned*)(F.lds + 131072))[u] = 0u;
    __syncthreads();
    volatile LAS unsigned* MISC = (volatile LAS unsigned*)(F.lds + MISC_OFF);
    XcdBarrier bar = xcd_barrier_post((unsigned*)a.ws + a.li * 4096, MISC + 8, F.wave);
    const int lo = a.ph_lo, hi = a.ph_hi;
#ifndef PROBE_PHASE
#define PROBE_PHASE -1
#endif
#ifndef PROBE_REPS
#define PROBE_REPS 3
#endif
#define PH(k) if (lo <= (k) && (k) < hi) for (int _r = 0; _r < ((k) == PROBE_PHASE ? PROBE_REPS : 1); ++_r)
#define INS(k) (lo <= (k) && (k) < hi)
#define SEAM(k) do { if (INS(k) && INS((k) + 1)) xcd_barrier(bar); } while (0)
    PH(0) { p0_prologue(F); } SEAM(0);
    PH(1) { p1_modulate_bf16(F); } SEAM(1);
    PH(2) {
        pg8::Gemm g{F.h1b, F.w_in_t, NTOK, IN_WIDTH, D_MODEL}; pg8::StaticOrder S; S.init(NTOK, IN_WIDTH, F.G, (int)blockIdx.x);
        pg8::EpiBf16P E{F.projb, IN_WIDTH, 0};
        pg8::gemm_phase<pg8::EpiBf16P, pg8::StaticOrder, true, true>(F.lds, g, S, E, F.wave);
    } SEAM(2);
    PH(3) { ph_attn(F); ph_rot2(F); } SEAM(3);
    PH(4) { ph_ret_a(F); } SEAM(4);
    PH(5) { ph_ret_scan2(F); } SEAM(5);
    PH(6) { ph_ret_b(F); } SEAM(6);
    PH(7) {
        pg8::Gemm g{F.ycatb, F.w_out_t, NTOK, D_MODEL, D_MODEL}; pg8::StaticOrder S; S.init(NTOK, D_MODEL, F.G, (int)blockIdx.x);
        pg8::EpiF32Mid E{F.mixer, D_MODEL, 16, F.ssq};
        pg8::gemm_phase<pg8::EpiF32Mid, pg8::StaticOrder, true, true>(F.lds, g, S, E, F.wave);
    } SEAM(7);
    PH(8) { ph_res_ln2<false, false>(F, F.x, F.mixer, nullptr, 2 * D_MODEL, F.ln1_g, F.ln1_b, nullptr, F.x1b, 3 * D_MODEL, 4 * D_MODEL, F.h2b); } SEAM(8);
    PH(9) {
        pg8::Gemm g{F.h2b, F.wr_t, NTOK, 768, D_MODEL}; pg8::StaticOrder S; S.init(NTOK, 768, F.G, (int)blockIdx.x);
        pg8::EpiF32 E{F.rsg, 768, 0};
        pg8::gemm_phase<pg8::EpiF32, pg8::StaticOrder, true, true>(F.lds, g, S, E, F.wave);
    } SEAM(9);
    PH(10) { ph_route2(F); ph_swiglu2(F); } SEAM(10);
    PH(11) { moe_stage<0>(F, _r);
        pg8::Gemm g{F.sactb, F.ws_down_t, NTOK, D_MODEL, 256}; pg8::StaticOrder S; S.init(NTOK, D_MODEL, F.G, (int)blockIdx.x);
        pg8::EpiF32 E{F.sh_out, D_MODEL, 0};
        pg8::gemm_phase<pg8::EpiF32, pg8::StaticOrder, true, true>(F.lds, g, S, E, F.wave);
    } SEAM(11);
    PH(12) { moe_stage<1>(F, _r); } SEAM(12);
    PH(13) { ph_res_ln2<true, true>(F, F.x1b, F.sh_out, F.contribb, 5 * D_MODEL, F.ln2_g, F.ln2_b, F.out, nullptr, 0, 0, nullptr); }
#undef PH
#undef SEAM
}

extern "C" void kernel_launch(void* const* d_in, const int* in_sizes, int n_in, void* d_out, int out_size, void* d_ws, size_t ws_size, hipStream_t stream) {
    static int grid = 0;
    if (grid == 0) {
        int dev = 0, cus = 0, per_cu = 0;
        if (hipGetDevice(&dev) != hipSuccess || hipDeviceGetAttribute(&cus, hipDeviceAttributeMultiprocessorCount, dev) != hipSuccess) { fprintf(stderr, "kernel_launch: device query failed\n"); grid = -1; return; }
        if (hipFuncSetAttribute((const void*)mk_fwd, hipFuncAttributeMaxDynamicSharedMemorySize, LDS_BYTES) != hipSuccess) { fprintf(stderr, "kernel_launch: hipFuncSetAttribute failed\n"); grid = -1; return; }
        if (hipOccupancyMaxActiveBlocksPerMultiprocessor(&per_cu, (const void*)mk_fwd, 512, LDS_BYTES) != hipSuccess || per_cu < 1)
            fprintf(stderr, "kernel_launch: occupancy query reports %d workgroups per CU\n", per_cu);
        (void)hipGetLastError();
        grid = cus;
    }
    if (grid < 0) return;
    if (hipMemsetAsync(d_ws, 0, WS_CTL_BYTES, stream) != hipSuccess) { fprintf(stderr, "kernel_launch: memset failed\n"); return; }
    Args a{};
    for (int i = 0; i < 21; ++i) a.in[i] = (const float*)d_in[i];
    a.out = (float*)d_out; a.ws = (unsigned char*)d_ws;
    for (int li = 0; li < MK_N_LAUNCHES; ++li) {
        a.ph_lo = li * N_PHASES / MK_N_LAUNCHES; a.ph_hi = (li + 1) * N_PHASES / MK_N_LAUNCHES; a.li = li;
        hipLaunchKernelGGL(mk_fwd, dim3(grid), dim3(512), LDS_BYTES, stream, a);
        const hipError_t le = hipPeekAtLastError();
        if (le != hipSuccess) { fprintf(stderr, "kernel_launch: launch %d failed: %s\n", li, hipGetErrorName(le)); break; }
    }
}
```
